# Optimizing an MI355X kernel written in HIP

```python
import math
import jax, jax.numpy as jnp
from jax import lax
import numpy as np

D_MODEL = 1024
BATCH = 8
SEQ = 8192
DEPTH = 1

CHUNK = 64
Q_BLOCK = 128
D_MIX = D_MODEL
ATT_WIDTH = D_MIX // 2
POOL_WIDTH = D_MIX - ATT_WIDTH
N_DIFF_HEADS = 4
DIFF_HEAD_DIM = ATT_WIDTH // N_DIFF_HEADS // 2
DIFF_V_DIM = 2 * DIFF_HEAD_DIM
POOL_WINDOWS = (2, 4, 8, 16)
N_POOL_GROUPS = len(POOL_WINDOWS)
POOL_GROUP_DIM = POOL_WIDTH // N_POOL_GROUPS
D_FF = ((8 * D_MODEL // 3 + 255) // 256) * 256
ROPE_THETA = 10000.0
NORM_EPS = 1e-6
LAMBDA_INIT_SCALE = 0.1
IN_WIDTH = 3 * ATT_WIDTH + POOL_WIDTH

kernel_name = "hybrid_diffattn_pool_macaron"


def rms_norm(x, g):
    xf = x.astype(jnp.float32)
    y = xf * lax.rsqrt(jnp.mean(xf * xf, axis=-1, keepdims=True) + NORM_EPS)
    return (y * g.astype(jnp.float32)).astype(x.dtype)


def swiglu(h, w_gate, w_up, w_down):
    return (jax.nn.silu(h @ w_gate) * (h @ w_up)) @ w_down


def rope_tables(seq, dim):
    pos = jnp.arange(seq, dtype=jnp.float32)
    inv_freq = 1.0 / (ROPE_THETA ** (jnp.arange(0, dim, 2, dtype=jnp.float32) / dim))
    ang = pos[:, None] * inv_freq[None, :]
    return jnp.cos(ang), jnp.sin(ang)


def apply_rope(t, cos, sin):
    tf = t.astype(jnp.float32)
    t1, t2 = jnp.split(tf, 2, axis=-1)
    c = cos[:, None, None, :]
    s = sin[:, None, None, :]
    out = jnp.concatenate([t1 * c - t2 * s, t1 * s + t2 * c], axis=-1)
    return out.astype(t.dtype)


def diff_attention(q, k, v, lam):
    B, S, H, _, Dh = q.shape
    nb = S // Q_BLOCK
    scale = DIFF_HEAD_DIM ** -0.5
    qb = (q * scale).reshape(B, nb, Q_BLOCK, H, 2, Dh).transpose(1, 4, 0, 3, 2, 5)
    kt = k.transpose(3, 0, 2, 1, 4)
    vt = v.transpose(0, 2, 1, 3)
    key_chunk = jnp.arange(S) // CHUNK

    def block(args):
        q_blk, bi = args
        q_chunk = (bi * Q_BLOCK + jnp.arange(Q_BLOCK)) // CHUNK
        mask = key_chunk[None, :] <= q_chunk[:, None]
        s = jnp.einsum('mbhqd,mbhkd->mbhqk', q_blk, kt).astype(jnp.float32)
        s = jnp.where(mask, s, -jnp.inf)
        p = jax.nn.softmax(s, axis=-1)
        a = p[0] - lam * p[1]
        return jnp.einsum('bhqk,bhkd->bhqd', a.astype(vt.dtype), vt)

    out = lax.map(block, (qb, jnp.arange(nb)))
    return out.transpose(1, 0, 3, 2, 4).reshape(B, S, H, DIFF_V_DIM)


def pool_mixer(u, w, scale):
    B, S, _ = u.shape
    ug = u.reshape(B, S, N_POOL_GROUPS, POOL_GROUP_DIM)
    ugf = ug.astype(jnp.float32)
    cs = jnp.cumsum(ugf, axis=1)
    t = jnp.arange(S)
    means = []
    for gi, win in enumerate(POOL_WINDOWS):
        c = cs[:, :, gi]
        lag = jnp.pad(c, ((0, 0), (win, 0), (0, 0)))[:, :S]
        cnt = jnp.minimum(t + 1, win).astype(jnp.float32)[None, :, None]
        means.append((c - lag) / cnt)
    d = (jnp.stack(means, axis=2) - ugf).astype(u.dtype)
    y = jnp.einsum('bsgc,gcd->bsgd', d, w)
    return y.reshape(B, S, POOL_WIDTH) * scale


def setup_inputs(seed: int = 0) -> dict:
    key = jax.random.key(seed)
    ks = jax.random.split(key, 24)
    f32 = jnp.float32

    def normal(k, shape, fan_in):
        return jax.random.normal(k, shape, f32) * (fan_in ** -0.5)

    def gain(k, shape):
        return 1.0 + 0.02 * jax.random.normal(k, shape, f32)

    return {
        "x": jax.random.normal(ks[0], (BATCH, SEQ, D_MODEL), f32),
        "ffn1_norm": gain(ks[1], (DEPTH, D_MODEL)),
        "ffn1_w_gate": normal(ks[2], (DEPTH, D_MODEL, D_FF), D_MODEL),
        "ffn1_w_up": normal(ks[3], (DEPTH, D_MODEL, D_FF), D_MODEL),
        "ffn1_w_down": normal(ks[4], (DEPTH, D_FF, D_MODEL), D_FF),
        "mix_norm": gain(ks[5], (DEPTH, D_MODEL)),
        "w_in": normal(ks[6], (DEPTH, D_MODEL, IN_WIDTH), D_MODEL),
        "lambda_q1": LAMBDA_INIT_SCALE * jax.random.normal(ks[7], (DEPTH, DIFF_HEAD_DIM), f32),
        "lambda_k1": LAMBDA_INIT_SCALE * jax.random.normal(ks[8], (DEPTH, DIFF_HEAD_DIM), f32),
        "lambda_q2": LAMBDA_INIT_SCALE * jax.random.normal(ks[9], (DEPTH, DIFF_HEAD_DIM), f32),
        "lambda_k2": LAMBDA_INIT_SCALE * jax.random.normal(ks[10], (DEPTH, DIFF_HEAD_DIM), f32),
        "subln_gain": gain(ks[11], (DEPTH, DIFF_V_DIM)),
        "pool_w": normal(ks[12], (DEPTH, N_POOL_GROUPS, POOL_GROUP_DIM, POOL_GROUP_DIM), POOL_GROUP_DIM),
        "pool_scale": 1.0 + 0.1 * jax.random.normal(ks[13], (DEPTH, POOL_WIDTH), f32),
        "w_out": normal(ks[14], (DEPTH, D_MIX, D_MODEL), D_MIX),
        "ffn2_norm": gain(ks[15], (DEPTH, D_MODEL)),
        "ffn2_w_gate": normal(ks[16], (DEPTH, D_MODEL, D_FF), D_MODEL),
        "ffn2_w_up": normal(ks[17], (DEPTH, D_MODEL, D_FF), D_MODEL),
        "ffn2_w_down": normal(ks[18], (DEPTH, D_FF, D_MODEL), D_FF),
        "final_norm": gain(ks[19], (D_MODEL,)),
    }


def reference(x, ffn1_norm, ffn1_w_gate, ffn1_w_up, ffn1_w_down, mix_norm, w_in,
              lambda_q1, lambda_k1, lambda_q2, lambda_k2, subln_gain, pool_w, pool_scale,
              w_out, ffn2_norm, ffn2_w_gate, ffn2_w_up, ffn2_w_down, final_norm):
    B, S, _ = x.shape
    cos, sin = rope_tables(S, DIFF_HEAD_DIM)
    for l in range(DEPTH):
        x = x + 0.5 * swiglu(rms_norm(x, ffn1_norm[l]), ffn1_w_gate[l], ffn1_w_up[l], ffn1_w_down[l])

        h = rms_norm(x, mix_norm[l])
        proj = h @ w_in[l]
        q = proj[..., :ATT_WIDTH].reshape(B, S, N_DIFF_HEADS, 2, DIFF_HEAD_DIM)
        k = proj[..., ATT_WIDTH:2 * ATT_WIDTH].reshape(B, S, N_DIFF_HEADS, 2, DIFF_HEAD_DIM)
        v = proj[..., 2 * ATT_WIDTH:3 * ATT_WIDTH].reshape(B, S, N_DIFF_HEADS, DIFF_V_DIM)
        u = proj[..., 3 * ATT_WIDTH:]

        q = apply_rope(q, cos, sin)
        k = apply_rope(k, cos, sin)
        lam_init = 0.8 - 0.6 * math.exp(-0.3 * l)
        lam = (jnp.exp(jnp.sum(lambda_q1[l].astype(jnp.float32) * lambda_k1[l].astype(jnp.float32)))
               - jnp.exp(jnp.sum(lambda_q2[l].astype(jnp.float32) * lambda_k2[l].astype(jnp.float32)))
               + lam_init)
        att = diff_attention(q, k, v, lam)
        att = (rms_norm(att, subln_gain[l]) * (1.0 - lam_init)).reshape(B, S, ATT_WIDTH)

        pool = pool_mixer(u, pool_w[l], pool_scale[l])

        x = x + jnp.concatenate([att.astype(x.dtype), pool.astype(x.dtype)], axis=-1) @ w_out[l]

        x = x + 0.5 * swiglu(rms_norm(x, ffn2_norm[l]), ffn2_w_gate[l], ffn2_w_up[l], ffn2_w_down[l])
    return rms_norm(x, final_norm)
```

```cpp
#define MK_N_LAUNCHES 1
#define MK_PROBE_MASK 0
#include <hip/hip_runtime.h>
#include <cstdio>
#include <cstdint>
namespace pg8 {
#define PG8_LAS __attribute__((address_space(3)))
typedef unsigned short bf16_t;
typedef short bf16x8 __attribute__((ext_vector_type(8)));
typedef float f32x4 __attribute__((ext_vector_type(4)));
typedef unsigned u32x4 __attribute__((ext_vector_type(4)));
constexpr int BM = 256, BK = 64, HALF = 128, HTB = HALF * BK * 2  , STAGE_BYTES = 8 * HTB, NXCD = 8, WGM = 8;

__host__ __device__ __forceinline__ int lds_byte(int r, int c) { const int st = (r >> 4) * 2 + (c >> 5), rr = r & 15, cc = c & 31, ob = rr * 64 + cc * 2; return st * 1024 + (ob ^ (((ob >> 9) & 1) << 5)); }
__host__ __device__ __forceinline__ void stage_rc(int b, int& R, int& C) { const int st = b / 1024, sb = b % 1024, swz = sb ^ (((sb >> 9) & 1) << 5); R = (st >> 1) * 16 + swz / 64; C = (st & 1) * 32 + (swz % 64) / 2; }
__host__ __device__ __forceinline__ int perm32(int rho) { const int n = rho >> 4, i = rho & 15; return 8 * (i >> 2) + 4 * n + (i & 3); }

struct Unit { int pm, pn; };
struct Gemm { const bf16_t* A; const bf16_t* Bt; int M, N, K; };

struct StaticOrder {
    int nM, nN, nwg, G, c;
    __host__ __device__ void init(int M, int N, int G_, int c_) { nM = M / BM; nN = N / BM; nwg = nM * nN; G = G_; c = c_; }
    __host__ __device__ bool next(int i, Unit& u) const {
        const long L = (long)i * G + c; if (L >= nwg) return false;
        int wgid = (int)L; { const int q = nwg / NXCD, r = nwg % NXCD, xcd = wgid % NXCD, off = wgid / NXCD; wgid = (xcd < r ? xcd * (q + 1) : r * (q + 1) + (xcd - r) * q) + off; }
        const int nig = WGM * nN, gid = wgid / nig, fm = gid * WGM, gsz = (nM - fm) < WGM ? (nM - fm) : WGM;
        u.pm = fm + ((wgid % nig) % gsz); u.pn = (wgid % nig) / gsz; return true;
    }
    __device__ __forceinline__ void a_ready(const Unit&) const {}
    __device__ __forceinline__ void done(const Unit&) const {}
};


__device__ __forceinline__ unsigned cvt_pk_bf16(float lo, float hi) { unsigned r; asm("v_cvt_pk_bf16_f32 %0, %1, %2" : "=v"(r) : "v"(lo), "v"(hi)); return r; }
__device__ __forceinline__ u32x4 pack8(const f32x4 a, const f32x4 b) { u32x4 w; w.x = cvt_pk_bf16(a[0], a[1]); w.y = cvt_pk_bf16(a[2], a[3]); w.z = cvt_pk_bf16(b[0], b[1]); w.w = cvt_pk_bf16(b[2], b[3]); return w; }
__device__ __forceinline__ void unpack8(const u32x4 w, f32x4& a, f32x4& b) {
    a[0] = __uint_as_float(w.x << 16); a[1] = __uint_as_float(w.x & 0xffff0000u); a[2] = __uint_as_float(w.y << 16); a[3] = __uint_as_float(w.y & 0xffff0000u);
    b[0] = __uint_as_float(w.z << 16); b[1] = __uint_as_float(w.z & 0xffff0000u); b[2] = __uint_as_float(w.w << 16); b[3] = __uint_as_float(w.w & 0xffff0000u); }
constexpr float RMS_EPS = 1e-6f;
__device__ __forceinline__ float rstd_of(float ssq) { return __builtin_amdgcn_rsqf(ssq * (1.0f / 1024.0f) + RMS_EPS); }

struct EpiPlain {
    static constexpr bool PERM = true, AFTER_DRAIN = false;
    bf16_t* O; int ldc; int coff;
    __device__ __forceinline__ void prefetch(float (&)[8], const Unit&, int, int) const {}
    __device__ __forceinline__ void operator()(const f32x4 (&acc)[2][2][4][2], const Unit& u, int wr, int wc, int fr, int fq, const float (&)[8]) const {
        const int row0 = u.pm * BM + wr * 64 + fr, col0 = coff + u.pn * BM + wc * 32 + 8 * fq;
#pragma unroll
        for (int ai = 0; ai < 2; ++ai)
#pragma unroll
            for (int m = 0; m < 4; ++m) { bf16_t* rowp = O + (size_t)(row0 + ai * HALF + m * 16) * ldc + col0;
#pragma unroll
                for (int bj = 0; bj < 2; ++bj) *(u32x4*)(rowp + bj * HALF) = pack8(acc[ai][bj][m][0], acc[ai][bj][m][1]); }
    }
};
constexpr float H8_SCALE = 8.0f, W8_SCALE = 64.0f;
__device__ __forceinline__ unsigned pk4_fp8(float a, float b, float c, float d) {
    a = __builtin_fminf(__builtin_fmaxf(a, -448.f), 448.f); b = __builtin_fminf(__builtin_fmaxf(b, -448.f), 448.f); c = __builtin_fminf(__builtin_fmaxf(c, -448.f), 448.f); d = __builtin_fminf(__builtin_fmaxf(d, -448.f), 448.f);
    unsigned w = 0u; w = __builtin_amdgcn_cvt_pk_fp8_f32(a, b, w, false); w = __builtin_amdgcn_cvt_pk_fp8_f32(c, d, w, true); return w; }
template <bool F8OUT> struct EpiSwiglu {
    static constexpr bool PERM = true, AFTER_DRAIN = false;
    bf16_t* O; const float* ssq;
    __device__ __forceinline__ void prefetch(float (&pre)[8], const Unit& u, int wr, int fr) const {
#pragma unroll
        for (int i = 0; i < 8; ++i) pre[i] = ssq[u.pm * BM + wr * 64 + fr + (i >> 2) * HALF + (i & 3) * 16]; }
    __device__ __forceinline__ void operator()(const f32x4 (&acc)[2][2][4][2], const Unit& u, int wr, int wc, int fr, int fq, const float (&pre)[8]) const {
        typedef float f32x2 __attribute__((ext_vector_type(2)));
        const int row0 = u.pm * BM + wr * 64 + fr, col0 = u.pn * HALF + wc * 32 + 8 * fq;
#pragma unroll
        for (int ai = 0; ai < 2; ++ai)
#pragma unroll
            for (int m = 0; m < 4; ++m) { const int row = row0 + ai * HALF + m * 16; const float rs = rstd_of(pre[ai * 4 + m]), nrl = rs * -1.4426950408889634f, rs2 = rs * rs;
                f32x4 o[2];
#pragma unroll
                for (int n = 0; n < 2; ++n)
#pragma unroll
                    for (int e = 0; e < 4; e += 2) { const f32x2 g = (f32x2){acc[ai][0][m][n][e], acc[ai][0][m][n][e + 1]}, up = (f32x2){acc[ai][1][m][n][e], acc[ai][1][m][n][e + 1]};
                        const f32x2 t = g * nrl; f32x2 d; d.x = __builtin_amdgcn_exp2f(t.x); d.y = __builtin_amdgcn_exp2f(t.y); d = d + 1.0f;
                        f32x2 sg; sg.x = __builtin_amdgcn_rcpf(d.x); sg.y = __builtin_amdgcn_rcpf(d.y);
                        const f32x2 r = ((g * up) * rs2) * sg; o[n][e] = r.x; o[n][e + 1] = r.y; }
                if constexpr (F8OUT) { typedef unsigned u32x2_ __attribute__((ext_vector_type(2))); const f32x4 s0 = o[0] * H8_SCALE, s1 = o[1] * H8_SCALE;
                    *(u32x2_*)((unsigned char*)O + (size_t)row * 2816 + col0) = (u32x2_){pk4_fp8(s0[0], s0[1], s0[2], s0[3]), pk4_fp8(s1[0], s1[1], s1[2], s1[3])}; }
                else { *(u32x4*)(O + (size_t)row * 2816 + col0) = pack8(o[0], o[1]); } }
    }
};
template <bool OUTF32> struct EpiRes {
    static constexpr bool PERM = true, AFTER_DRAIN = false;
    const bf16_t* res; void* out; float* ssq; float alpha;
    __device__ __forceinline__ void prefetch(float (&)[8], const Unit&, int, int) const {}
    __device__ __forceinline__ void operator()(const f32x4 (&acc)[2][2][4][2], const Unit& u, int wr, int wc, int fr, int fq, const float (&)[8]) const {
        const int row0 = u.pm * BM + wr * 64 + fr, col0 = u.pn * BM + wc * 32 + 8 * fq;
        u32x4 rr[2][4][2];
#pragma unroll
        for (int ai = 0; ai < 2; ++ai)
#pragma unroll
            for (int m = 0; m < 4; ++m)
#pragma unroll
                for (int bj = 0; bj < 2; ++bj) rr[ai][m][bj] = *(const u32x4*)(res + (size_t)(row0 + ai * HALF + m * 16) * 1024 + col0 + bj * HALF);
        asm volatile("" ::: "memory");
#pragma unroll
        for (int ai = 0; ai < 2; ++ai)
#pragma unroll
            for (int m = 0; m < 4; ++m) { const int row = row0 + ai * HALF + m * 16; const size_t off = (size_t)row * 1024 + col0; float s = 0.f;
#pragma unroll
                for (int bj = 0; bj < 2; ++bj) { f32x4 r0, r1; unpack8(rr[ai][m][bj], r0, r1);
                    const f32x4 v0 = r0 + acc[ai][bj][m][0] * alpha, v1 = r1 + acc[ai][bj][m][1] * alpha;
                    s += (v0[0] * v0[0] + v0[1] * v0[1]) + (v0[2] * v0[2] + v0[3] * v0[3]) + (v1[0] * v1[0] + v1[1] * v1[1]) + (v1[2] * v1[2] + v1[3] * v1[3]);
                    if (OUTF32) { *(f32x4*)((float*)out + off + bj * HALF) = v0; *(f32x4*)((float*)out + off + bj * HALF + 4) = v1; }
                    else { *(u32x4*)((bf16_t*)out + off + bj * HALF) = pack8(v0, v1); } }
                s += __shfl_xor(s, 16); s += __shfl_xor(s, 32);
                if (fq == 0) __hip_atomic_fetch_add(ssq + row, s, __ATOMIC_RELAXED, __HIP_MEMORY_SCOPE_AGENT); }
    }
};
struct EpiWin {
    static constexpr bool PERM = true, AFTER_DRAIN = false;
    bf16_t *q, *k, *v, *uu; const float* ssq; const float* cst; float qscale;
    __device__ __forceinline__ void prefetch(float (&pre)[8], const Unit& u, int wr, int fr) const {
#pragma unroll
        for (int i = 0; i < 8; ++i) pre[i] = ssq[u.pm * BM + wr * 64 + fr + (i >> 2) * HALF + (i & 3) * 16]; }
    __device__ __forceinline__ void operator()(const f32x4 (&acc)[2][2][4][2], const Unit& u, int wr, int wc, int fr, int fq, const float (&pre)[8]) const {
        const int row0 = u.pm * BM + wr * 64 + fr, pn = u.pn;
        if (pn < 4) {
            bf16_t* dst = (pn < 2) ? q : k; const float sc = (pn < 2) ? qscale : 1.0f; const int colb = (pn & 1) * 256 + 64 * wc + 8 * fq;
#pragma unroll
            for (int ai = 0; ai < 2; ++ai)
#pragma unroll
                for (int m = 0; m < 4; ++m) { const int row = row0 + ai * HALF + m * 16; const float rs = rstd_of(pre[ai * 4 + m]) * sc; const int pos = row & 8191;
                    const f32x4* t4 = (const f32x4*)(cst + ((size_t)pos * 32 + 8 * fq) * 2);
                    f32x4 o1[2], o2[2];
#pragma unroll
                    for (int n = 0; n < 2; ++n) { const f32x4 ta = t4[2 * n], tb = t4[2 * n + 1]; const f32x4 x1 = acc[ai][0][m][n] * rs, x2 = acc[ai][1][m][n] * rs;
                        o1[n][0] = x1[0] * ta[0] - x2[0] * ta[1]; o2[n][0] = x1[0] * ta[1] + x2[0] * ta[0];
                        o1[n][1] = x1[1] * ta[2] - x2[1] * ta[3]; o2[n][1] = x1[1] * ta[3] + x2[1] * ta[2];
                        o1[n][2] = x1[2] * tb[0] - x2[2] * tb[1]; o2[n][2] = x1[2] * tb[1] + x2[2] * tb[0];
                        o1[n][3] = x1[3] * tb[2] - x2[3] * tb[3]; o2[n][3] = x1[3] * tb[3] + x2[3] * tb[2]; }
                    bf16_t* rowp = dst + (size_t)row * 512 + colb;
                    *(u32x4*)(rowp) = pack8(o1[0], o1[1]); *(u32x4*)(rowp + 32) = pack8(o2[0], o2[1]);
                    if (m & 1) asm volatile("" ::: "memory"); }
        } else {
            bf16_t* dst = (pn < 6) ? v : uu; const int colb = (pn & 1) * 256 + wc * 32 + 8 * fq;
#pragma unroll
            for (int ai = 0; ai < 2; ++ai)
#pragma unroll
                for (int m = 0; m < 4; ++m) { const int row = row0 + ai * HALF + m * 16; const float rs = rstd_of(pre[ai * 4 + m]); bf16_t* rowp = dst + (size_t)row * 512 + colb;
#pragma unroll
                    for (int bj = 0; bj < 2; ++bj) *(u32x4*)(rowp + bj * HALF) = pack8(acc[ai][bj][m][0] * rs, acc[ai][bj][m][1] * rs); }
        }
    }
};

template <class Epi, class Sched, bool ALIGN_EPI = false, bool SP2 = false, bool F8 = false>
__device__ __forceinline__ void gemm_phase(PG8_LAS unsigned char* lds, const Gemm g, const Sched& S, const Epi& E) {
    const int tid = threadIdx.x, wid = __builtin_amdgcn_readfirstlane(tid >> 6), lane = tid & 63, wr = wid >> 2, wc = wid & 3, fr = lane & 15, fq = lane >> 4;
    const int K = g.K, nt = K / BK;
    unsigned voffA[2], voffB[2];
#pragma unroll
    for (int i = 0; i < 2; ++i) { int R, C; stage_rc(tid * 16 + i * 8192, R, C); const int Rb = Epi::PERM ? ((R & ~31) + perm32(R & 31)) : R;
        voffA[i] = (unsigned)(R * K + C) * 2u; voffB[i] = (unsigned)(Rb * K + C) * 2u; }
    const size_t kstep = (size_t)(BK * 2);
    const size_t hstep = (size_t)HALF * K * 2;
    const size_t tstep = 2 * hstep;
    const unsigned ldsw = (unsigned)wid * 1024u;
    const int aoff = lds_byte(wr * 64 + fr, fq * 8), boff = lds_byte(wc * 32 + fr, fq * 8);
#define PG8_SA(b, h) (((b) * 2 + (h)) * HTB)
#define PG8_SB(b, h) ((4 + (b) * 2 + (h)) * HTB)
#define PG8_STAGE(bufoff, gbase, voff) do { _Pragma("unroll") for (int _i = 0; _i < 2; ++_i) \
        __builtin_amdgcn_global_load_lds((const unsigned*)((const char*)(gbase) + (voff)[_i]), (PG8_LAS unsigned*)(lds + (bufoff) + ldsw + _i * 8192), 16, 0, 0); } while (0)
#define PG8_LDA(dst, b, h) do { _Pragma("unroll") for (int m = 0; m < 4; ++m) _Pragma("unroll") for (int k = 0; k < 2; ++k) dst[m][k] = *(const PG8_LAS bf16x8*)(lds + PG8_SA(b, h) + aoff + m * 2048 + k * 1024); } while (0)
#define PG8_LDB(dst, b, h) do { _Pragma("unroll") for (int n = 0; n < 2; ++n) _Pragma("unroll") for (int k = 0; k < 2; ++k) dst[n][k] = *(const PG8_LAS bf16x8*)(lds + PG8_SB(b, h) + boff + n * 2048 + k * 1024); } while (0)
#define PG8_MMA(ai, bj, At, Bt) do { __builtin_amdgcn_s_setprio(1); _Pragma("unroll") for (int m = 0; m < 4; ++m) _Pragma("unroll") for (int n = 0; n < 2; ++n) { \
        if constexpr (F8) { typedef int v4i_ __attribute__((ext_vector_type(4))); typedef int v8i_ __attribute__((ext_vector_type(8))); \
            const v8i_ a8 = __builtin_shufflevector(__builtin_bit_cast(v4i_, At[m][0]), __builtin_bit_cast(v4i_, At[m][1]), 0, 1, 2, 3, 4, 5, 6, 7), b8 = __builtin_shufflevector(__builtin_bit_cast(v4i_, Bt[n][0]), __builtin_bit_cast(v4i_, Bt[n][1]), 0, 1, 2, 3, 4, 5, 6, 7); \
            asm("v_mfma_f32_16x16x128_f8f6f4 %0, %1, %2, %0" : "+v"(acc[ai][bj][m][n]) : "v"(b8), "v"(a8)); } \
        else { _Pragma("unroll") for (int k = 0; k < 2; ++k) acc[ai][bj][m][n] = __builtin_amdgcn_mfma_f32_16x16x32_bf16(Bt[n][k], At[m][k], acc[ai][bj][m][n], 0, 0, 0); } } \
        __builtin_amdgcn_s_setprio(0); } while (0)
#define PG8_WAIT_V(n) asm volatile("s_waitcnt vmcnt(" #n ")" ::: "memory")
#define PG8_WAIT_L(n) asm volatile("s_waitcnt lgkmcnt(" #n ")" ::: "memory")
#define PG8_BAR __builtin_amdgcn_s_barrier()
#define PG8_SCHED __builtin_amdgcn_sched_barrier(0)
    Unit cur, nxt; int ui = 0;
    if (!S.next(0, cur)) return;
    f32x4 acc[2][2][4][2];
    float pre[8];
#pragma unroll
    for (int i = 0; i < 8; ++i) pre[i] = 0.f;
#pragma unroll
    for (int a = 0; a < 2; ++a)
#pragma unroll
        for (int b = 0; b < 2; ++b)
#pragma unroll
            for (int m = 0; m < 4; ++m)
#pragma unroll
                for (int n = 0; n < 2; ++n) acc[a][b][m][n] = (f32x4){0.f, 0.f, 0.f, 0.f};
    bf16x8 At[4][2], B0[2][2], B1[2][2];
    const char* cA = (const char*)g.A + (size_t)cur.pm * tstep; const char* cB = (const char*)g.Bt + (size_t)cur.pn * tstep;
    S.a_ready(cur);
    if constexpr (SP2) {
        PG8_STAGE(PG8_SB(0, 0), cB, voffB); PG8_STAGE(PG8_SB(0, 1), cB + hstep, voffB); PG8_STAGE(PG8_SA(0, 0), cA, voffA); PG8_STAGE(PG8_SA(0, 1), cA + hstep, voffA);
        if (wr == 1) PG8_BAR;
        PG8_WAIT_V(2); PG8_BAR;
        PG8_STAGE(PG8_SB(1, 0), cB + kstep, voffB); PG8_STAGE(PG8_SA(1, 0), cA + kstep, voffA); PG8_STAGE(PG8_SB(1, 1), cB + hstep + kstep, voffB);
        PG8_WAIT_V(6); PG8_BAR;
    } else {
        PG8_STAGE(PG8_SB(0, 0), cB, voffB); PG8_STAGE(PG8_SA(0, 0), cA, voffA); PG8_STAGE(PG8_SB(0, 1), cB + hstep, voffB); PG8_STAGE(PG8_SA(0, 1), cA + hstep, voffA);
        if (wr == 1) PG8_BAR;
        PG8_WAIT_V(4); PG8_BAR;
        PG8_STAGE(PG8_SB(1, 0), cB + kstep, voffB); PG8_STAGE(PG8_SA(1, 0), cA + kstep, voffA); PG8_STAGE(PG8_SB(1, 1), cB + hstep + kstep, voffB);
        PG8_WAIT_V(6); PG8_BAR;
    }
    for (;;) {
        const bool has_next = S.next(ui + 1, nxt);
        const char* nA = has_next ? (const char*)g.A + (size_t)nxt.pm * tstep : cA; const char* nB = has_next ? (const char*)g.Bt + (size_t)nxt.pn * tstep : cB;
        for (int t = 0; t < nt; t += 2) {
            const bool last = (t == nt - 2);
            const char* a1 = cA + (size_t)(t + 1) * kstep;
            const char* a2 = last ? nA : cA + (size_t)(t + 2) * kstep; const char* b2 = last ? nB : cB + (size_t)(t + 2) * kstep;
            const char* a3 = a2 + kstep; const char* b3 = b2 + kstep;
            if (last && has_next) S.a_ready(nxt);
            if (last) E.prefetch(pre, cur, wr, fr);
            if constexpr (SP2) {
            PG8_LDB(B0, 0, 0); PG8_LDB(B1, 0, 1); PG8_SCHED; PG8_LDA(At, 0, 0); PG8_STAGE(PG8_SA(1, 1), a1 + hstep, voffA);
            PG8_WAIT_V(8); PG8_WAIT_L(0); PG8_BAR; PG8_MMA(0, 0, At, B0); PG8_MMA(0, 1, At, B1); PG8_BAR; PG8_SCHED;
            PG8_LDA(At, 0, 1); PG8_STAGE(PG8_SB(0, 0), b2, voffB); PG8_STAGE(PG8_SB(0, 1), b2 + hstep, voffB); PG8_STAGE(PG8_SA(0, 0), a2, voffA);
            PG8_WAIT_V(8); PG8_WAIT_L(0); PG8_BAR; PG8_MMA(1, 0, At, B0); PG8_MMA(1, 1, At, B1); PG8_BAR; PG8_SCHED;
            PG8_LDB(B0, 1, 0); PG8_LDB(B1, 1, 1); PG8_SCHED; PG8_LDA(At, 1, 0); PG8_STAGE(PG8_SA(0, 1), a2 + hstep, voffA);
            PG8_WAIT_V(8); PG8_WAIT_L(0); PG8_BAR; PG8_MMA(0, 0, At, B0); PG8_MMA(0, 1, At, B1); PG8_BAR; PG8_SCHED;
            PG8_LDA(At, 1, 1); PG8_STAGE(PG8_SB(1, 0), b3, voffB); PG8_STAGE(PG8_SB(1, 1), b3 + hstep, voffB); PG8_STAGE(PG8_SA(1, 0), a3, voffA);
            PG8_WAIT_V(8); PG8_WAIT_L(0); PG8_BAR; PG8_MMA(1, 0, At, B0); PG8_MMA(1, 1, At, B1); PG8_BAR; PG8_SCHED;
            } else {
            PG8_LDB(B0, 0, 0); PG8_SCHED; PG8_LDA(At, 0, 0); PG8_STAGE(PG8_SA(1, 1), a1 + hstep, voffA);
            PG8_WAIT_L(8); PG8_BAR; PG8_WAIT_L(0); PG8_MMA(0, 0, At, B0); PG8_BAR; PG8_SCHED;
            PG8_LDB(B1, 0, 1); PG8_STAGE(PG8_SB(0, 0), b2, voffB);
            PG8_BAR; PG8_WAIT_L(0); PG8_MMA(0, 1, At, B1); PG8_BAR;
            PG8_LDA(At, 0, 1); PG8_STAGE(PG8_SA(0, 0), a2, voffA);
            PG8_BAR; PG8_WAIT_L(0); PG8_MMA(1, 0, At, B0); PG8_BAR; PG8_SCHED;
            PG8_STAGE(PG8_SB(0, 1), b2 + hstep, voffB);
            PG8_WAIT_V(6); PG8_BAR; PG8_MMA(1, 1, At, B1); PG8_BAR;
            PG8_LDB(B0, 1, 0); PG8_SCHED; PG8_LDA(At, 1, 0); PG8_STAGE(PG8_SA(0, 1), a2 + hstep, voffA);
            PG8_WAIT_L(8); PG8_BAR; PG8_WAIT_L(0); PG8_MMA(0, 0, At, B0); PG8_BAR; PG8_SCHED;
            PG8_LDB(B1, 1, 1); PG8_STAGE(PG8_SB(1, 0), b3, voffB);
            PG8_BAR; PG8_WAIT_L(0); PG8_MMA(0, 1, At, B1); PG8_BAR;
            PG8_LDA(At, 1, 1); PG8_STAGE(PG8_SA(1, 0), a3, voffA);
            PG8_BAR; PG8_WAIT_L(0); PG8_MMA(1, 0, At, B0); PG8_BAR; PG8_SCHED;
            PG8_STAGE(PG8_SB(1, 1), b3 + hstep, voffB);
            PG8_WAIT_V(6); PG8_BAR; PG8_MMA(1, 1, At, B1); PG8_BAR;
            }
        }
        if constexpr (F8) { asm volatile("s_nop 15\n\ts_nop 15" ::: "memory"); }
        if constexpr (ALIGN_EPI) { if (wr == 0) PG8_BAR; }
        if constexpr (!Epi::AFTER_DRAIN) { E(acc, cur, wr, wc, fr, fq, pre); S.done(cur); }
        if (!has_next) break;
#pragma unroll
        for (int a = 0; a < 2; ++a)
#pragma unroll
            for (int b = 0; b < 2; ++b)
#pragma unroll
                for (int m = 0; m < 4; ++m)
#pragma unroll
                    for (int n = 0; n < 2; ++n) acc[a][b][m][n] = (f32x4){0.f, 0.f, 0.f, 0.f};
        cur = nxt; cA = nA; cB = nB; ++ui;
        if constexpr (ALIGN_EPI) { if (wr == 1) PG8_BAR; }
    }
    PG8_WAIT_V(0);
    if constexpr (!ALIGN_EPI) { if (wr == 0) PG8_BAR; }
    PG8_BAR;
    if constexpr (Epi::AFTER_DRAIN) { E.fused(acc, cur, wr, wc, fr, fq, lds, wid, lane); S.done(cur); }
#undef PG8_SA
#undef PG8_SB
#undef PG8_STAGE
#undef PG8_LDA
#undef PG8_LDB
#undef PG8_MMA
#undef PG8_WAIT_V
#undef PG8_WAIT_L
#undef PG8_BAR
#undef PG8_SCHED
}
}
#include <hip/hip_bf16.h>
#include <cmath>
namespace attn_body {
using bf16=__hip_bfloat16;
using bf16x8=__attribute__((ext_vector_type(8)))short;
using s16x4=__attribute__((ext_vector_type(4)))short;
using f32x16=__attribute__((ext_vector_type(16)))float;
using u32x4=__attribute__((ext_vector_type(4)))unsigned;
constexpr int SEQ=8192,D=64,PQK=512,PV=512,PO=1024;
constexpr int NW=8,QBLK=32,QB=QBLK*NW,KVBLK=64,NQB=SEQ/QB;
constexpr int ATTN_UNIT_ROWS=QB;
__device__ __forceinline__ int crow(int r,int hi){return (r&3)+8*(r>>2)+4*hi;}
#define SBAR() __builtin_amdgcn_sched_barrier(0)
__device__ __forceinline__ void cmask(f32x16&p0,f32x16&p1,int jb,int qrel,int hi){
  const float NEG=-INFINITY; (void)hi;
  #pragma unroll
  for(int r=0;r<16;++r){ if(jb>(qrel>>6)){p0[r]=NEG; p1[r]=NEG;} }
}

constexpr int NSLOT=3, SLOTB=8192;
constexpr int LDS_K=0, LDS_V=NSLOT*SLOTB, LDS_WS=2*NSLOT*SLOTB, LDS_OST=LDS_WS+NW*64*4, LDS_BYTES=LDS_OST+NW*4096;
constexpr float C2=0.125f*1.4426950408889634f;
__device__ __forceinline__ void glds16(const void*gsrc,unsigned lds_dst){unsigned keep;
  asm volatile("s_mov_b32 %0, m0\n\ts_mov_b32 m0, %2\n\ts_nop 0\n\tglobal_load_lds_dwordx4 %1, off\n\ts_mov_b32 m0, %0":"=&s"(keep):"v"(gsrc),"s"(lds_dst):"memory");}
__device__ __forceinline__ float max3f(float a,float b,float c){float r;asm("v_max3_f32 %0, %1, %2, %3":"=v"(r):"v"(a),"v"(b),"v"(c));return r;}
__device__ __forceinline__ float max2f(float a,float b){float r;asm("v_max_f32_e32 %0, %1, %2":"=v"(r):"v"(a),"v"(b));return r;}
__device__ __forceinline__ float fadd_s(float a,float b){float r;asm("v_add_f32_e32 %0, %1, %2":"=v"(r):"v"(a),"v"(b));return r;}
__device__ __forceinline__ float fsub_s(float a,float b){float r;asm("v_sub_f32_e32 %0, %1, %2":"=v"(r):"v"(a),"v"(b));return r;}
typedef float f32x2_t __attribute__((ext_vector_type(2))); typedef __bf16 bf16x2_t __attribute__((ext_vector_type(2)));
__device__ __forceinline__ unsigned cvtpk_s(float lo,float hi){f32x2_t v={lo,hi};bf16x2_t b=__builtin_convertvector(v,bf16x2_t);return __builtin_bit_cast(unsigned,b);}
#define WAIT_BAR(N) asm volatile("s_waitcnt vmcnt(" #N ") lgkmcnt(0)\n\ts_barrier":::"memory")

__device__ __forceinline__ void qkt(f32x16&p0,f32x16&p1,const char*Kslot,const bf16x8*qr,const f32x16&negm,int r32,int hi){
  const char*kb=Kslot+hi*1024+r32*16;
  #pragma unroll
  for(int d0=0;d0<4;++d0){
    const bf16x8 b0=*reinterpret_cast<const bf16x8*>(kb+d0*2048);
    const bf16x8 b1=*reinterpret_cast<const bf16x8*>(kb+d0*2048+512);
    if(d0==0){p0=__builtin_amdgcn_mfma_f32_32x32x16_bf16(b0,qr[0],negm,0,0,0);p1=__builtin_amdgcn_mfma_f32_32x32x16_bf16(b1,qr[0],negm,0,0,0);}
    else{p0=__builtin_amdgcn_mfma_f32_32x32x16_bf16(b0,qr[d0],p0,0,0,0);p1=__builtin_amdgcn_mfma_f32_32x32x16_bf16(b1,qr[d0],p1,0,0,0);}}
}
typedef __attribute__((address_space(3))) const char* lds_cptr;
typedef short v4i16_t __attribute__((ext_vector_type(4)));
__device__ __forceinline__ void kload8(bf16x8*kf,lds_cptr kp){
  kf[0]=*(const __attribute__((address_space(3))) bf16x8*)(kp);      kf[1]=*(const __attribute__((address_space(3))) bf16x8*)(kp+512);
  kf[2]=*(const __attribute__((address_space(3))) bf16x8*)(kp+2048); kf[3]=*(const __attribute__((address_space(3))) bf16x8*)(kp+2560);
  kf[4]=*(const __attribute__((address_space(3))) bf16x8*)(kp+4096); kf[5]=*(const __attribute__((address_space(3))) bf16x8*)(kp+4608);
  kf[6]=*(const __attribute__((address_space(3))) bf16x8*)(kp+6144); kf[7]=*(const __attribute__((address_space(3))) bf16x8*)(kp+6656);
}
__device__ __forceinline__ void kload2(bf16x8*kf,lds_cptr kp,int j){ kf[2*j]=*(const __attribute__((address_space(3))) bf16x8*)(kp+j*2048); kf[2*j+1]=*(const __attribute__((address_space(3))) bf16x8*)(kp+j*2048+512); }
__device__ __forceinline__ s16x4 vtr(lds_cptr p){ return __builtin_bit_cast(s16x4,__builtin_amdgcn_ds_read_tr16_b64_v4i16((__attribute__((address_space(3))) v4i16_t*)p)); }
__device__ __forceinline__ float rowmax(const f32x16&p0,const f32x16&p1){
  float a=max3f(p0[0],p0[1],p1[0]),b=max3f(p0[2],p0[3],p1[1]);a=max3f(a,p1[2],p1[3]);
  #pragma unroll
  for(int r=4;r<16;r+=4){a=max3f(a,p0[r],p0[r+1]);b=max3f(b,p0[r+2],p0[r+3]);a=max3f(a,p1[r],p1[r+1]);b=max3f(b,p1[r+2],p1[r+3]);}
  const float m=max2f(a,b);
  auto rr=__builtin_amdgcn_permlane32_swap(__float_as_uint(m),__float_as_uint(m),false,false);
  return max2f(__uint_as_float(rr[0]),__uint_as_float(rr[1]));
}
__device__ __forceinline__ void pv(f32x16*o,int vb,bf16x8 pa0,bf16x8 pa1,bf16x8 pa2,bf16x8 pa3){
  #pragma unroll
  for(int d0=0;d0<2;++d0){s16x4 lo[4],hi[4];
    #pragma unroll
    for(int ks=0;ks<4;++ks){
      asm volatile("ds_read_b64_tr_b16 %0,%1 offset:%c2":"=&v"(lo[ks]):"v"(vb),"i"(d0*4096+ks*1024):"memory");
      asm volatile("ds_read_b64_tr_b16 %0,%1 offset:%c2":"=&v"(hi[ks]):"v"(vb),"i"(d0*4096+ks*1024+512):"memory");}
    asm volatile("s_waitcnt lgkmcnt(0)":::"memory");SBAR();
    #define PK(k) (bf16x8){lo[k][0],lo[k][1],lo[k][2],lo[k][3],hi[k][0],hi[k][1],hi[k][2],hi[k][3]}
    o[d0]=__builtin_amdgcn_mfma_f32_32x32x16_bf16(pa0,PK(0),o[d0],0,0,0);
    o[d0]=__builtin_amdgcn_mfma_f32_32x32x16_bf16(pa1,PK(1),o[d0],0,0,0);
    o[d0]=__builtin_amdgcn_mfma_f32_32x32x16_bf16(pa2,PK(2),o[d0],0,0,0);
    o[d0]=__builtin_amdgcn_mfma_f32_32x32x16_bf16(pa3,PK(3),o[d0],0,0,0);
    #undef PK
  }
}

#ifndef ATTN_STORE16
#define ATTN_STORE16(p,v) (*(u32x4*)(p)=(v))
#endif
template<int THRL> __device__ __forceinline__ void attn_unit(int b,int qb,const bf16*Qh,const bf16*__restrict__ Kh_,const bf16*__restrict__ Vh_,bf16*Oh,char*shm){
  const int tid=threadIdx.x,lane=tid&63,r32=lane&31,hi=lane>>5; const int wid=__builtin_amdgcn_readfirstlane(tid>>6);
  const long rowbase=(long)b*SEQ; const int q0=qb*QB;
  const bf16*Qw=Qh+(rowbase+q0+wid*QBLK)*PQK;
  const bf16*Kh=Kh_+rowbase*PQK,*Vh=Vh_+rowbase*PV;
  const unsigned lds0=(unsigned)(uintptr_t)shm;
  float*wsf=(float*)(shm+LDS_WS)+wid*64;
  const bf16*ksrc=Kh+(long)lane*PQK+wid*8;
  const bf16*vsrc=Vh+(long)(16*(wid&3)+(lane>>2))*PV+(wid>>2)*32+(lane&3)*8;
  const unsigned kdst=lds0+LDS_K+wid*1024, vdst=lds0+LDS_V+wid*1024;
  #define DMA_K(t,slot) glds16(ksrc+(long)(t)*KVBLK*PQK,(unsigned)__builtin_amdgcn_readfirstlane(kdst+(slot)))
  #define DMA_V(t,slot) glds16(vsrc+(long)(t)*KVBLK*PV,(unsigned)__builtin_amdgcn_readfirstlane(vdst+(slot)))
  const int vb0=(int)(lds0+LDS_V)+((lane>>4)&1)*32+(lane&3)*8+(4*hi+((lane&15)>>2))*64;
  const char*Kbase=shm+LDS_K; bf16x8 kf[8];
  const lds_cptr shm3=(lds_cptr)shm; const lds_cptr kp0=shm3+LDS_K+hi*1024+r32*16; const lds_cptr vp0=shm3+LDS_V+((lane>>4)&1)*32+(lane&3)*8+(4*hi+((lane&15)>>2))*64;
  const int NT=(q0+QB)/KVBLK;
  DMA_K(0,0);DMA_V(0,0);DMA_K(1,SLOTB);
  bf16x8 qr[4];
  #pragma unroll
  for(int d0=0;d0<4;++d0)qr[d0]=*reinterpret_cast<const bf16x8*>(&Qw[(long)r32*PQK+d0*16+hi*8]);
  float mhat=0.f,l_reg=0.f;f32x16 o[2];o[0]=f32x16{};o[1]=f32x16{};f32x16 negm=f32x16{};asm volatile("":"+v"(negm));
  const int qrel=wid*QBLK+r32;
  #define CMASK(P0,P1,t) do{int jb_=(t)-(NT-4); if(jb_>=0)cmask(P0,P1,jb_,qrel,hi);}while(0)
  bool resc=false;
  #define START(P0,P1) do{ const float rm=rowmax(P0,P1); resc=false; \
    { const float dl=rm; mhat=fadd_s(mhat,dl); \
      _Pragma("unroll") for(int r=0;r<16;++r){P0[r]=fsub_s(P0[r],dl);P1[r]=fsub_s(P1[r],dl);} \
      _Pragma("unroll") for(int r=0;r<16;++r)negm[r]=-mhat; asm volatile("":"+v"(negm)); } \
    _Pragma("unroll") for(int r=0;r<16;++r)P0[r]=__builtin_amdgcn_exp2f(P0[r]); }while(0)
  #define RESC() do{ if(resc){ asm volatile("s_waitcnt lgkmcnt(0)":::"memory"); \
      _Pragma("unroll") for(int d_=0;d_<2;++d_) _Pragma("unroll") for(int r=0;r<16;++r)o[d_][r]*=wsf[crow(r,hi)]; } }while(0)
  f32x16 pA0,pA1,pB0,pB1;
  int sl_prev=0,sl_cur=0,sl_next=SLOTB;
  #define ROT() do{sl_prev=sl_cur;sl_cur=sl_next;sl_next=(sl_next==(NSLOT-1)*SLOTB)?0:sl_next+SLOTB;}while(0)
  DMA_K(2,2*SLOTB);
  WAIT_BAR(3);
  qkt(pA0,pA1,Kbase,qr,negm,r32,hi);asm volatile("s_nop 15\n\ts_nop 7":"+v"(pA0),"+v"(pA1));CMASK(pA0,pA1,0);
  START(pA0,pA1);
  _Pragma("unroll") for(int r=0;r<16;++r)pA1[r]=__builtin_amdgcn_exp2f(pA1[r]);
  WAIT_BAR(0);
  DMA_K(3,0);DMA_V(1,SLOTB);
  ROT();
  kload8(kf,kp0+sl_cur);
  WAIT_BAR(2);
  s16x4 vlo[8],vhi[8]; u32x4 pw0,pw1,pw2,pw3;
  #define PKW(P,B) cvtpk_s(P[B],P[B+1])
  #define PAF(k) __builtin_bit_cast(bf16x8,pw##k)
  #define VFR(i) (bf16x8){vlo[i][0],vlo[i][1],vlo[i][2],vlo[i][3],vhi[i][0],vhi[i][1],vhi[i][2],vhi[i][3]}
  #define PIN(x) asm volatile("":"+v"(x))
  #define MX3(a,b,c) __builtin_fmaxf(__builtin_fmaxf((a),(b)),(c))
  #define GAPA(MF,A0,A1,A2,A3,W0,W1,PW) do{ MF; sacc+=A0; sacc+=A1; sacc+=A2; sacc+=A3; PIN(sacc); W0; W1; PIN(PW); SBAR(); }while(0)
  #define EX(v) __builtin_amdgcn_exp2f(v)
  #define GAPB(MF,X,B) do{ MF; X[B]=EX(X[B]); X[B+1]=EX(X[B+1]); X[B+2]=EX(X[B+2]); X[B+3]=EX(X[B+3]); PIN(X); SBAR(); }while(0)
  #define VRD(i) do{ vlo[i]=vtr(vp_+(((i)>>2)*4096+((i)&3)*1024)); vhi[i]=vtr(vp_+(((i)>>2)*4096+((i)&3)*1024+512)); }while(0)
  #define KRD(G,j) do{ if(G){ kload2(kf,kp0+sl_next,j); SBAR(); } }while(0)
  #define STEP(C0,C1,P0,P1,t,GK,GV,GL) do{ SBAR(); \
    const lds_cptr vp_=vp0+sl_prev; \
    VRD(0); SBAR(); float sacc=(P0[0]+P0[1]); \
    GAPA(C0=__builtin_amdgcn_mfma_f32_32x32x16_bf16(kf[0],qr[0],negm,0,0,0), P0[2],P0[3],P0[4],P0[5],     pw0[0]=PKW(P0,0), pw0[1]=PKW(P0,2), pw0); \
    VRD(4); SBAR(); GAPA(C1=__builtin_amdgcn_mfma_f32_32x32x16_bf16(kf[1],qr[0],negm,0,0,0), P0[6],P0[7],P0[8],P0[9],     pw0[2]=PKW(P0,4), pw0[3]=PKW(P0,6), pw0); \
    VRD(1); SBAR(); GAPA(C0=__builtin_amdgcn_mfma_f32_32x32x16_bf16(kf[2],qr[1],C0,0,0,0),   P0[10],P0[11],P0[12],P0[13], pw1[0]=PKW(P0,8), pw1[1]=PKW(P0,10), pw1); \
    VRD(5); SBAR(); GAPA(C1=__builtin_amdgcn_mfma_f32_32x32x16_bf16(kf[3],qr[1],C1,0,0,0),   P0[14],P0[15],P1[0],P1[1],   pw1[2]=PKW(P0,12),pw1[3]=PKW(P0,14), pw1); \
    VRD(2); SBAR(); GAPA(C0=__builtin_amdgcn_mfma_f32_32x32x16_bf16(kf[4],qr[2],C0,0,0,0),   P1[2],P1[3],P1[4],P1[5],     pw2[0]=PKW(P1,0), pw2[1]=PKW(P1,2), pw2); \
    VRD(6); SBAR(); GAPA(C1=__builtin_amdgcn_mfma_f32_32x32x16_bf16(kf[5],qr[2],C1,0,0,0),   P1[6],P1[7],P1[8],P1[9],     pw2[2]=PKW(P1,4), pw2[3]=PKW(P1,6), pw2); \
    VRD(3); SBAR(); GAPA(C0=__builtin_amdgcn_mfma_f32_32x32x16_bf16(kf[6],qr[3],C0,0,0,0),   P1[10],P1[11],P1[12],P1[13], pw3[0]=PKW(P1,8), pw3[1]=PKW(P1,10), pw3); \
    VRD(7); SBAR(); GAPA(C1=__builtin_amdgcn_mfma_f32_32x32x16_bf16(kf[7],qr[3],C1,0,0,0),   P1[14],P1[15],0.f,0.f,       pw3[2]=PKW(P1,12),pw3[3]=PKW(P1,14), pw3); \
    l_reg+=sacc; \
    if(GK){DMA_K((t)+3,sl_cur);} if(GV){DMA_V((t)+1,sl_next);} \
    CMASK(C0,C1,t); \
    { float a=MX3(C0[0],C0[1],C1[0]),b=MX3(C0[2],C0[3],C1[1]); a=MX3(a,C1[2],C1[3]); \
      _Pragma("unroll") for(int r=4;r<16;r+=4){a=MX3(a,C0[r],C0[r+1]);b=MX3(b,C0[r+2],C0[r+3]);a=MX3(a,C1[r],C1[r+1]);b=MX3(b,C1[r+2],C1[r+3]);} \
      float rm=__builtin_fmaxf(a,b); { auto rr=__builtin_amdgcn_permlane32_swap(__float_as_uint(rm),__float_as_uint(rm),false,false); rm=__builtin_fmaxf(__uint_as_float(rr[0]),__uint_as_float(rr[1])); } \
      resc=false; \
      if(__builtin_expect(__any(rm>(float)THRL),0)){ const float dl=__builtin_fmaxf(rm,0.f); mhat+=dl; \
        _Pragma("unroll") for(int r=0;r<16;++r){C0[r]-=dl;C1[r]-=dl;} \
        _Pragma("unroll") for(int r=0;r<16;++r)negm[r]=-mhat; asm volatile("":"+v"(negm)); \
        const float f=__builtin_amdgcn_exp2f(-dl); l_reg*=f; if(hi==0)wsf[r32]=f; resc=true; } } \
    SBAR(); \
    GAPB(o[0]=__builtin_amdgcn_mfma_f32_32x32x16_bf16(PAF(0),VFR(0),o[0],0,0,0), C0,0); \
    GAPB(o[1]=__builtin_amdgcn_mfma_f32_32x32x16_bf16(PAF(0),VFR(4),o[1],0,0,0), C0,4); \
    KRD(GL,0); GAPB(o[0]=__builtin_amdgcn_mfma_f32_32x32x16_bf16(PAF(1),VFR(1),o[0],0,0,0), C0,8); \
    KRD(GL,1); GAPB(o[1]=__builtin_amdgcn_mfma_f32_32x32x16_bf16(PAF(1),VFR(5),o[1],0,0,0), C0,12); \
    KRD(GL,2); GAPB(o[0]=__builtin_amdgcn_mfma_f32_32x32x16_bf16(PAF(2),VFR(2),o[0],0,0,0), C1,0); \
    KRD(GL,3); GAPB(o[1]=__builtin_amdgcn_mfma_f32_32x32x16_bf16(PAF(2),VFR(6),o[1],0,0,0), C1,4); \
    GAPB(o[0]=__builtin_amdgcn_mfma_f32_32x32x16_bf16(PAF(3),VFR(3),o[0],0,0,0), C1,8); \
    GAPB(o[1]=__builtin_amdgcn_mfma_f32_32x32x16_bf16(PAF(3),VFR(7),o[1],0,0,0), C1,12); \
    }while(0)
  int t=1;
  #undef CMASK
  #define CMASK(P0,P1,t) do{}while(0)
  for(;t+5<NT;t+=2){
    STEP(pB0,pB1,pA0,pA1,t,true,true,true);     WAIT_BAR(2); RESC(); ROT();
    STEP(pA0,pA1,pB0,pB1,t+1,true,true,true);   WAIT_BAR(2); RESC(); ROT();
  }
  #undef CMASK
  #define CMASK(P0,P1,t) do{int jb_=(t)-(NT-4); if(jb_>=0)cmask(P0,P1,jb_,qrel,hi);}while(0)
  #define ENDW(tt) do{ if((tt)+3<NT){WAIT_BAR(2);} else if((tt)+2<NT){WAIT_BAR(1);} else {WAIT_BAR(0);} }while(0)
  for(;t+1<NT;t+=2){
    STEP(pB0,pB1,pA0,pA1,t,(t+3<NT),(t+1<NT),(t+1<NT));       ENDW(t);   RESC(); ROT();
    STEP(pA0,pA1,pB0,pB1,t+1,(t+4<NT),(t+2<NT),(t+2<NT));     ENDW(t+1); RESC(); ROT();
  }
  STEP(pB0,pB1,pA0,pA1,NT-1,false,false,false); RESC();
  { float sacc=pB0[0]+pB0[1]; _Pragma("unroll") for(int r=2;r<16;++r)sacc+=pB0[r]; _Pragma("unroll") for(int r=0;r<16;++r)sacc+=pB1[r]; l_reg+=sacc;
    pw0=(u32x4){PKW(pB0,0),PKW(pB0,2),PKW(pB0,4),PKW(pB0,6)};pw1=(u32x4){PKW(pB0,8),PKW(pB0,10),PKW(pB0,12),PKW(pB0,14)};pw2=(u32x4){PKW(pB1,0),PKW(pB1,2),PKW(pB1,4),PKW(pB1,6)};pw3=(u32x4){PKW(pB1,8),PKW(pB1,10),PKW(pB1,12),PKW(pB1,14)};
    SBAR(); pv(o,vb0+sl_cur,PAF(0),PAF(1),PAF(2),PAF(3)); }
  #undef PKW
  #undef PAF
  #undef VFR
  #undef PIN
  #undef MX3
  #undef GAPA
  #undef GAPB
  #undef EX
  #undef VRD
  #undef KRD
  #undef STEP
  #undef ENDW
  {auto rr=__builtin_amdgcn_permlane32_swap(__float_as_uint(l_reg),__float_as_uint(l_reg),false,false);l_reg=__uint_as_float(rr[0])+__uint_as_float(rr[1]);}
  if(hi==0)wsf[32+r32]=l_reg;asm volatile("s_waitcnt lgkmcnt(0)":::"memory");
  float rli[16];
  #pragma unroll
  for(int r=0;r<16;++r)rli[r]=__builtin_amdgcn_rcpf(wsf[32+crow(r,hi)]);
  bf16*Ow=Oh+(rowbase+q0+wid*QBLK)*PO;
  { bf16*stg=(bf16*)(shm+LDS_OST)+wid*2048;
    #pragma unroll
    for(int r=0;r<16;++r){const int orow=crow(r,hi);
      #pragma unroll
      for(int d0=0;d0<2;++d0)stg[orow*64+d0*32+r32]=__float2bfloat16(o[d0][r]*rli[r]);}
    asm volatile("s_waitcnt lgkmcnt(0)":::"memory");
    #pragma unroll
    for(int i=0;i<4;++i){const int row=i*8+(lane>>3),ch=lane&7; const u32x4 v=*(const u32x4*)(stg+row*64+ch*8); ATTN_STORE16(Ow+(long)row*PO+ch*8,v);} }
  asm volatile("s_waitcnt lgkmcnt(0)\n\ts_barrier":::"memory");
  #undef DMA_K
  #undef DMA_V
  #undef CMASK
  #undef START
  #undef RESC
  #undef ROT
}
constexpr int ATTN_LDS_BYTES=LDS_BYTES;
struct AttnTensors { const bf16* Q; const bf16* K; const bf16* V; bf16* O; };
struct AttnUnit { int combo; int qb; };
struct StaticOrder {
  int vcu;
  __device__ __forceinline__ explicit StaticOrder(int v):vcu(v){}
  __device__ __forceinline__ bool next(int i,AttnUnit&u)const{ if(i>=16)return false; const int s=(vcu&1)*8+(i>>1); u.combo=vcu>>1; u.qb=(i&1)?31-s:s; return true; }
};
template<class Sched,int THRL=8> __device__ __forceinline__ void attn_phase(char*lds,const AttnTensors&T,const Sched&S){
  AttnUnit u;
  for(int i=0;S.next(i,u);++i){ const int half=u.combo&1, hm=(u.combo>>1)&7, b=u.combo>>4, h=hm>>1;
    attn_unit<THRL>(b,u.qb,T.Q+hm*64,T.K+hm*64,T.V+h*128+half*64,T.O+hm*128+half*64,lds); }
}
#undef SBAR
#undef WAIT_BAR
}

namespace attn2 {
using attn_body::bf16; using attn_body::bf16x8; using attn_body::s16x4; using attn_body::f32x16; using attn_body::u32x4; using attn_body::lds_cptr;
using attn_body::glds16; using attn_body::vtr; using attn_body::cvtpk_s; using attn_body::crow;
constexpr int SEQ = 8192, PQ = 512, PC = 1024, SLOT = 32768, NS = 4, LDS_WS = NS * SLOT, LDS_BYTES = LDS_WS + 8 * 64 * 4;
#define A2_LAS __attribute__((address_space(3)))
#define A2_SB() __builtin_amdgcn_sched_barrier(0)
#define A2_WAIT_BAR(N) asm volatile("s_waitcnt vmcnt(" #N ") lgkmcnt(0)\n\ts_barrier" ::: "memory")
template <int THRL, int MAP> __device__ __forceinline__ void attn_unit(int b, int h, int qb, int qbn, bool first, bf16x8 (&qr)[4], const bf16* Q, const bf16* __restrict__ K, const bf16* __restrict__ V, bf16* cat, float lam, const float* gain, char* shm) {
    const int tid = threadIdx.x, lane = tid & 63, r32 = lane & 31, hi = lane >> 5; const int wid = __builtin_amdgcn_readfirstlane(tid >> 6), wq = wid & 3; constexpr int map = MAP;
    const long rowbase = (long)b * SEQ; const int q0 = qb * 128;
    const bf16* Qw = Q + (rowbase + q0 + wq * 32) * PQ + (h * 2 + map) * 64;
    const unsigned lds0 = (unsigned)(uintptr_t)shm; const lds_cptr shm3 = (lds_cptr)shm;
    A2_LAS float* wsf = (A2_LAS float*)(shm3 + LDS_WS) + wid * 64;
    const bf16* ks0 = K + (rowbase + lane) * PQ + (h * 2) * 64 + wid * 8;
    const bf16* vsA = V + (rowbase + 16 * (wid & 3) + (lane >> 2)) * PQ + h * 128 + (wid >> 2) * 32 + (lane & 3) * 8;
#define A2_DMA(t, sl) do { const long o_ = (long)(t) * 64 * PQ; const unsigned d_ = (unsigned)__builtin_amdgcn_readfirstlane(lds0 + (unsigned)(sl) * SLOT + wid * 1024); \
        glds16(ks0 + o_, d_); glds16(ks0 + 64 + o_, d_ + 8192u); glds16(vsA + o_, d_ + 16384u); glds16(vsA + 64 + o_, d_ + 24576u); } while (0)
    if (first) {
#pragma unroll
        for (int d0 = 0; d0 < 4; ++d0) qr[d0] = *reinterpret_cast<const bf16x8*>(&Qw[(long)r32 * PQ + d0 * 16 + hi * 8]);
        A2_DMA(0, 0); A2_DMA(1, 1); }
    const lds_cptr kp0 = shm3 + map * 8192 + hi * 1024 + r32 * 16;
    const lds_cptr vp0 = shm3 + 16384 + ((lane >> 4) & 1) * 32 + (lane & 3) * 8 + (4 * hi + ((lane & 15) >> 2)) * 64;
    float mhat = 0.f, l_reg = 0.f; f32x16 o[4]; o[0] = f32x16{}; o[1] = f32x16{}; o[2] = f32x16{}; o[3] = f32x16{}; f32x16 negm = f32x16{};
    const int NT = 2 * (qb + 1), tvis = 2 * qb + (wq >> 1);
    u32x4 pw[4];
#define A2_PV16(vpx) do { const lds_cptr vq_ = (vpx); \
        _Pragma("unroll") for (int hf = 0; hf < 2; ++hf) { s16x4 wa[16]; \
            _Pragma("unroll") for (int i = 0; i < 8; ++i) { wa[2 * i] = vtr(vq_ + (2 * hf + (i >> 2)) * 4096 + (i & 3) * 1024); wa[2 * i + 1] = vtr(vq_ + (2 * hf + (i >> 2)) * 4096 + (i & 3) * 1024 + 512); } \
            A2_SB(); \
            _Pragma("unroll") for (int i = 0; i < 8; ++i) { const s16x4 lo = wa[2 * i], hh = wa[2 * i + 1]; const bf16x8 vf = (bf16x8){lo[0], lo[1], lo[2], lo[3], hh[0], hh[1], hh[2], hh[3]}; \
                o[2 * hf + (i >> 2)] = __builtin_amdgcn_mfma_f32_32x32x16_bf16(__builtin_bit_cast(bf16x8, pw[i & 3]), vf, o[2 * hf + (i >> 2)], 0, 0, 0); } \
            A2_SB(); } } while (0)
#define A2_QKS(t, FIRST) do { const lds_cptr kp = kp0 + ((t) & 3) * SLOT; bf16x8 kf[8]; \
        _Pragma("unroll") for (int d0 = 0; d0 < 4; ++d0) { kf[2 * d0] = *(const A2_LAS bf16x8*)(kp + d0 * 2048); kf[2 * d0 + 1] = *(const A2_LAS bf16x8*)(kp + d0 * 2048 + 512); } \
        A2_SB(); \
        f32x16 p0, p1; \
        p0 = __builtin_amdgcn_mfma_f32_32x32x16_bf16(kf[0], qr[0], negm, 0, 0, 0); p1 = __builtin_amdgcn_mfma_f32_32x32x16_bf16(kf[1], qr[0], negm, 0, 0, 0); \
        _Pragma("unroll") for (int d0 = 1; d0 < 4; ++d0) { p0 = __builtin_amdgcn_mfma_f32_32x32x16_bf16(kf[2 * d0], qr[d0], p0, 0, 0, 0); p1 = __builtin_amdgcn_mfma_f32_32x32x16_bf16(kf[2 * d0 + 1], qr[d0], p1, 0, 0, 0); } \
        A2_SB(); \
        float rm; \
        { float a = __builtin_fmaxf(__builtin_fmaxf(p0[0], p0[1]), p1[0]), c = __builtin_fmaxf(__builtin_fmaxf(p0[2], p0[3]), p1[1]); a = __builtin_fmaxf(__builtin_fmaxf(a, p1[2]), p1[3]); \
          _Pragma("unroll") for (int r = 4; r < 16; r += 4) { a = __builtin_fmaxf(__builtin_fmaxf(a, p0[r]), p0[r + 1]); c = __builtin_fmaxf(__builtin_fmaxf(c, p0[r + 2]), p0[r + 3]); a = __builtin_fmaxf(__builtin_fmaxf(a, p1[r]), p1[r + 1]); c = __builtin_fmaxf(__builtin_fmaxf(c, p1[r + 2]), p1[r + 3]); } \
          rm = __builtin_fmaxf(a, c); auto rr = __builtin_amdgcn_permlane32_swap(__float_as_uint(rm), __float_as_uint(rm), false, false); rm = __builtin_fmaxf(__uint_as_float(rr[0]), __uint_as_float(rr[1])); } \
        if (FIRST) { mhat = rm; \
            _Pragma("unroll") for (int r = 0; r < 16; ++r) { p0[r] -= rm; p1[r] -= rm; negm[r] = -mhat; } \
        } else if (__any(rm > (float)THRL)) {                                  \
            const float dl = __builtin_fmaxf(rm, 0.f); mhat += dl; \
            _Pragma("unroll") for (int r = 0; r < 16; ++r) { p0[r] -= dl; p1[r] -= dl; negm[r] = -mhat; } \
            const float f = __builtin_amdgcn_exp2f(-dl); l_reg *= f; if (hi == 0) wsf[r32] = f; \
            float fr[16]; \
            _Pragma("unroll") for (int r = 0; r < 16; ++r) fr[r] = wsf[crow(r, hi)]; \
            _Pragma("unroll") for (int d = 0; d < 4; ++d) _Pragma("unroll") for (int r = 0; r < 16; ++r) o[d][r] *= fr[r]; \
        } \
        float sacc = 0.f; \
        _Pragma("unroll") for (int r = 0; r < 16; ++r) { p0[r] = __builtin_amdgcn_exp2f(p0[r]); p1[r] = __builtin_amdgcn_exp2f(p1[r]); } \
        _Pragma("unroll") for (int r = 0; r < 16; ++r) sacc += p0[r] + p1[r]; \
        l_reg += sacc; \
        _Pragma("unroll") for (int j = 0; j < 4; ++j) { pw[0][j] = cvtpk_s(p0[2 * j], p0[2 * j + 1]); pw[1][j] = cvtpk_s(p0[8 + 2 * j], p0[8 + 2 * j + 1]); pw[2][j] = cvtpk_s(p1[2 * j], p1[2 * j + 1]); pw[3][j] = cvtpk_s(p1[8 + 2 * j], p1[8 + 2 * j + 1]); } \
        A2_SB(); } while (0)
    A2_WAIT_BAR(0); if (2 < NT) { A2_DMA(2, 2); }
    A2_QKS(0, true);
    if (MAP == 0) { A2_PV16(vp0); }
    for (int t = 1; t < NT; ++t) {
        if (t + 1 < NT) { A2_WAIT_BAR(4); } else { A2_WAIT_BAR(0); }
        if (t + 2 < NT) { A2_DMA(t + 2, (t + 2) & 3); }
        if (MAP == 1) { A2_PV16(vp0 + ((t - 1) & 3) * SLOT); }
        if (t <= tvis) { A2_QKS(t, false); if (MAP == 0) { A2_PV16(vp0 + (t & 3) * SLOT); } }
    }
    if (MAP == 1 && NT - 1 <= tvis) { A2_PV16(vp0 + ((NT - 1) & 3) * SLOT); }
    { auto rr = __builtin_amdgcn_permlane32_swap(__float_as_uint(l_reg), __float_as_uint(l_reg), false, false); l_reg = __uint_as_float(rr[0]) + __uint_as_float(rr[1]); }
    if (hi == 0) wsf[32 + r32] = l_reg;
    float rli[16];
#pragma unroll
    for (int r = 0; r < 16; ++r) rli[r] = __builtin_amdgcn_rcpf(wsf[32 + crow(r, hi)]);
#pragma unroll
    for (int d = 0; d < 4; ++d)
#pragma unroll
        for (int r = 0; r < 16; ++r) o[d][r] *= rli[r];
    A2_WAIT_BAR(0);
    if (qbn >= 0) {
        A2_DMA(0, 0); A2_DMA(1, 1);
        const bf16* Qn = Q + (rowbase + qbn * 128 + wq * 32) * PQ + (h * 2 + map) * 64;
#pragma unroll
        for (int d0 = 0; d0 < 4; ++d0) qr[d0] = *reinterpret_cast<const bf16x8*>(&Qn[(long)r32 * PQ + d0 * 16 + hi * 8]); }
    A2_LAS float* st = (A2_LAS float*)(shm3 + 2 * SLOT) + wq * 4096 + lane;
    if (map == 1) {
#pragma unroll
        for (int d = 0; d < 4; ++d)
#pragma unroll
            for (int r = 0; r < 16; ++r) st[(d * 16 + r) * 64] = o[d][r];
    }
    A2_WAIT_BAR(0);
    if (map == 0) {
        float g[4];
#pragma unroll
        for (int d = 0; d < 4; ++d) g[d] = gain[32 * d + r32] * 0.8f;
#pragma unroll
        for (int d = 0; d < 4; ++d)
#pragma unroll
            for (int r = 0; r < 16; ++r) o[d][r] -= lam * st[(d * 16 + r) * 64];
        bf16* orow = cat + (rowbase + q0 + wq * 32) * PC + h * 128 + r32;
#pragma unroll
        for (int r = 0; r < 16; ++r) { float ss = (o[0][r] * o[0][r] + o[1][r] * o[1][r]) + (o[2][r] * o[2][r] + o[3][r] * o[3][r]);
            ss += __shfl_xor(ss, 1); ss += __shfl_xor(ss, 2); ss += __shfl_xor(ss, 4); ss += __shfl_xor(ss, 8); ss += __shfl_xor(ss, 16);
            const float rs = 1.0f / sqrtf(ss * (1.0f / 128.0f) + 1e-6f); bf16* op = orow + (long)crow(r, hi) * PC;
#pragma unroll
            for (int d = 0; d < 4; ++d) op[32 * d] = __float2bfloat16(o[d][r] * rs * g[d]); }
    }
    A2_WAIT_BAR(0);
#undef A2_DMA
#undef A2_PV16
#undef A2_QKS
}
template <int THRL = 8> __device__ __forceinline__ void attn_phase(char* lds, int vcu, const bf16* Q, const bf16* K, const bf16* V, bf16* cat, float lam, const float* gain) {
    for (int v = vcu; v < 256; v += (int)gridDim.x) {
        const int bh = v >> 3, j = v & 7;
        bf16x8 qr[4];
        for (int i = 0; i < 8; ++i) { const int qb = 63 - 8 * i - ((i & 1) ? 7 - j : j), qbn = (i < 7) ? 63 - 8 * (i + 1) - (((i + 1) & 1) ? 7 - j : j) : -1;
            if ((threadIdx.x >> 8) == 0) attn_unit<THRL, 0>(bh >> 2, bh & 3, qb, qbn, i == 0, qr, Q, K, V, cat, lam, gain, lds); else attn_unit<THRL, 1>(bh >> 2, bh & 3, qb, qbn, i == 0, qr, Q, K, V, cat, lam, gain, lds); } }
}
#undef A2_WAIT_BAR
#undef A2_SB
#undef A2_LAS
}

#include <hip/hip_cooperative_groups.h>
namespace cg = cooperative_groups;

#ifndef MK_N_LAUNCHES
#define MK_N_LAUNCHES 1
#endif
constexpr int NWAVES = 8, NPH = 10;
constexpr int BATCH = 8, SEQL = 8192, DM = 1024, FF = 2816, NIN = 2048;
constexpr int M = BATCH * SEQL;
constexpr size_t MiB = 1u << 20;
constexpr size_t WS_SSQ = 0;
constexpr size_t WS_CST = 1 * MiB;
constexpr size_t WS_WGU1 = 4 * MiB, WS_WD1 = 16 * MiB, WS_WIN = 22 * MiB, WS_WOUT = 26 * MiB, WS_WPOOL = 28 * MiB, WS_WGU2 = 30 * MiB, WS_WD2 = 42 * MiB;
constexpr size_t WS_A = 64 * MiB;
constexpr size_t WS_B = 192 * MiB;
constexpr size_t WS_C = 544 * MiB;
constexpr size_t WS_D = 672 * MiB;
constexpr size_t WS_E = 800 * MiB;
constexpr size_t WS_END = 928 * MiB;
constexpr int RING_BYTES = 131072, LDS_BYTES = 147456;

#define GAS __attribute__((address_space(1)))
#define LAS __attribute__((address_space(3)))
typedef unsigned short bf16;
typedef unsigned v4u __attribute__((ext_vector_type(4)));
typedef float f32x4 __attribute__((ext_vector_type(4)));
#define LDS_WAIT() asm volatile("s_waitcnt lgkmcnt(0)" ::: "memory")
__device__ __forceinline__ unsigned f2bf(float f) { unsigned u = __builtin_bit_cast(unsigned, f); return (u + 0x7fffu + ((u >> 16) & 1u)) >> 16; }
__device__ __forceinline__ unsigned pk2(float lo, float hi) { return f2bf(lo) | (f2bf(hi) << 16); }
__device__ __forceinline__ float bflo(unsigned w) { return __uint_as_float(w << 16); }
__device__ __forceinline__ float bfhi(unsigned w) { return __uint_as_float(w & 0xffff0000u); }
__device__ __forceinline__ float wave_sum(float v) {
#pragma unroll
    for (int o = 1; o < 64; o <<= 1) v += __shfl_xor(v, o);
    return v;
}
__device__ __forceinline__ void p0_tr_item(const float* W, int ldw, int scol0, const float* gain, int k0, bf16* WT, int K, int drow0, LAS float* scr, int lane) {
    float tv[32];
#pragma unroll
    for (int i = 0; i < 32; ++i) { const int kk = 2 * i + (lane >> 5); tv[i] = W[(size_t)(k0 + kk) * ldw + scol0 + (lane & 31)]; }
    if (gain) {
#pragma unroll
        for (int i = 0; i < 32; ++i) tv[i] *= gain[k0 + 2 * i + (lane >> 5)]; }
#pragma unroll
    for (int i = 0; i < 32; ++i) scr[(2 * i + (lane >> 5)) * 33 + (lane & 31)] = tv[i];
    LDS_WAIT(); asm volatile("" ::: "memory");
    const int c = lane & 7;
#pragma unroll
    for (int j = 0; j < 4; ++j) { const int n = (lane >> 3) + 8 * j; const LAS float* s = scr + (8 * c) * 33 + n;
        v4u o; o.x = pk2(s[0 * 33], s[1 * 33]); o.y = pk2(s[2 * 33], s[3 * 33]); o.z = pk2(s[4 * 33], s[5 * 33]); o.w = pk2(s[6 * 33], s[7 * 33]);
        *(v4u*)(WT + (size_t)(drow0 + n) * K + k0 + 8 * c) = o; }
    LDS_WAIT(); asm volatile("" ::: "memory");
}

__device__ __forceinline__ void p0_tr_item_f8(const float* W, int ldw, int scol0, float scale, int k0, unsigned char* WT8, int K, int drow0, LAS float* scr, int lane) {
    float tv[32];
#pragma unroll
    for (int i = 0; i < 32; ++i) { const int kk = 2 * i + (lane >> 5); tv[i] = W[(size_t)(k0 + kk) * ldw + scol0 + (lane & 31)]; }
#pragma unroll
    for (int i = 0; i < 32; ++i) scr[(2 * i + (lane >> 5)) * 33 + (lane & 31)] = tv[i] * scale;
    LDS_WAIT(); asm volatile("" ::: "memory");
    const int c = lane & 7;
#pragma unroll
    for (int j = 0; j < 4; ++j) { const int n = (lane >> 3) + 8 * j; const LAS float* s = scr + (8 * c) * 33 + n;
        const unsigned lo = pg8::pk4_fp8(s[0 * 33], s[1 * 33], s[2 * 33], s[3 * 33]), hi = pg8::pk4_fp8(s[4 * 33], s[5 * 33], s[6 * 33], s[7 * 33]);
        *(unsigned long long*)(WT8 + (size_t)(drow0 + n) * K + k0 + 8 * c) = (unsigned long long)lo | ((unsigned long long)hi << 32); }
    LDS_WAIT(); asm volatile("" ::: "memory");
}

#define XB_TMO      128
#define XB_XCNT(j)  (256  + 64 * (j))
#define XB_XSUB(j)  (1280 + 64 * (j))
#define XB_XGEN(j)  (2304 + 64 * (j))
#define XB_TOP      3328
#define XB_TOPGEN   3392
#define XCD_BAR_WORDS 3456
#define XB_SPIN_CAP (1u << 18)

__device__ __forceinline__ unsigned xb_ld(unsigned* p)              { return __hip_atomic_load(p, __ATOMIC_RELAXED, __HIP_MEMORY_SCOPE_AGENT); }
__device__ __forceinline__ unsigned xb_add(unsigned* p, unsigned v) { return __hip_atomic_fetch_add(p, v, __ATOMIC_RELAXED, __HIP_MEMORY_SCOPE_AGENT); }
__device__ __forceinline__ unsigned xb_xcc_id() { return (unsigned)__builtin_amdgcn_s_getreg((3 << 11) | 20) & 0xFu; }
#define XB_SPIN(cond, bar) do { unsigned _sp = 0; while (cond) { __builtin_amdgcn_s_sleep(1); \
    if ((++_sp & 255u) == 0u) { if (xb_ld(&(bar)[XB_TMO])) break; if (_sp > XB_SPIN_CAP) { atomicAdd(&(bar)[XB_TMO], 1u); break; } } } } while (0)

struct XcdBarrier {
    unsigned* bar; unsigned x;
    volatile LAS unsigned* st;
};

__device__ __forceinline__ XcdBarrier xcd_barrier_post(unsigned* bar, volatile LAS unsigned* st) {
    XcdBarrier b; b.bar = bar; b.x = xb_xcc_id(); b.st = st;
    if (threadIdx.x == 0) (void)xb_add(&bar[XB_XCNT(b.x)], 1u);
    return b;
}
__device__ __forceinline__ void xcd_barrier_complete(unsigned* bar, unsigned x, unsigned& nloc, unsigned& nx) {
    const unsigned G = gridDim.x * gridDim.y * gridDim.z;
    unsigned sum, cnt, mine, sp = 0u;
    for (;;) {
        sum = 0u; cnt = 0u; mine = 0u;
#pragma unroll
        for (unsigned j = 0; j < 16; ++j) { const unsigned c = xb_ld(&bar[XB_XCNT(j)]); sum += c; cnt += (c > 0u) ? 1u : 0u; mine = (j == x) ? c : mine; }
        if (sum == G) break;
        __builtin_amdgcn_s_sleep(1);
        if ((++sp & 255u) == 0u) { if (xb_ld(&bar[XB_TMO])) break; if (sp > XB_SPIN_CAP) { atomicAdd(&bar[XB_TMO], 1u); break; } }
    }
    nloc = mine > 0u ? mine : 1u; nx = cnt > 0u ? cnt : 1u;
}

__device__ __forceinline__ void xcd_barrier(const XcdBarrier& b) {
    asm volatile("s_waitcnt vmcnt(0)" ::: "memory");
    __syncthreads();
    if (threadIdx.x == 0) {
        unsigned* bar = b.bar;
        __builtin_amdgcn_s_waitcnt(0);
        unsigned nloc = b.st[0], nx = b.st[1];
        if (nloc == 0u) { xcd_barrier_complete(bar, b.x, nloc, nx); b.st[0] = nloc; b.st[1] = nx; }
        const unsigned old = xb_add(&bar[XB_XSUB(b.x)], 1u);
        const unsigned gen = old / nloc;
        if (old + 1u == (gen + 1u) * nloc) {
            __builtin_amdgcn_fence(__ATOMIC_RELEASE, "agent");
            asm volatile("s_waitcnt vmcnt(0)" ::: "memory");
            const unsigned og = xb_add(&bar[XB_TOP], 1u);
            const unsigned tg = og / nx;
            if (og + 1u == (tg + 1u) * nx) xb_add(&bar[XB_TOPGEN], 1u);
            else XB_SPIN(xb_ld(&bar[XB_TOPGEN]) == tg, bar);
            __builtin_amdgcn_fence(__ATOMIC_ACQUIRE, "agent");
            xb_add(&bar[XB_XGEN(b.x)], 1u);
            asm volatile("s_waitcnt vmcnt(0)" ::: "memory");
        } else {
            XB_SPIN(xb_ld(&bar[XB_XGEN(b.x)]) == gen, bar);
            __builtin_amdgcn_fence(__ATOMIC_ACQUIRE, "agent");
            asm volatile("s_waitcnt vmcnt(0)" ::: "memory");
        }
    }
    __syncthreads();
}

constexpr size_t WS_BAR = 53 * MiB;
constexpr int MISC_OFF = LDS_BYTES - 64;

struct Args { const float* in[20]; float* out; unsigned char* ws; int ph_lo, ph_hi, dummy, pad; };

__global__ void __launch_bounds__(NWAVES * 64, 2) mk_fwd(Args args) {
    extern __shared__ __attribute__((aligned(16))) unsigned char lds[];
    LAS unsigned char* L = (LAS unsigned char*)lds;
    const int tid = threadIdx.x, lane = tid & 63, wave = __builtin_amdgcn_readfirstlane(tid >> 6);
    const int G = gridDim.x, bx = blockIdx.x, vcu = (G % 8 == 0) ? (bx % 8) * (G / 8) + bx / 8 : bx;
    const int gw = vcu * NWAVES + wave, NGW = G * NWAVES;
    unsigned char* ws = args.ws;
    const float* x = args.in[0];
    float* ssq0 = (float*)(ws + WS_SSQ); float* ssq1 = ssq0 + M; float* ssq2 = ssq1 + M; float* ssq3 = ssq2 + M;
    float* cst = (float*)(ws + WS_CST);
    if (args.dummy) { ssq1 = (float*)(ws + 50 * MiB); ssq2 = ssq1; ssq3 = ssq1; }
    bf16 *Wgu1 = (bf16*)(ws + WS_WGU1), *Wd1 = (bf16*)(ws + WS_WD1), *Win = (bf16*)(ws + WS_WIN), *Wout = (bf16*)(ws + WS_WOUT), *Wgu2 = (bf16*)(ws + WS_WGU2), *Wd2 = (bf16*)(ws + WS_WD2);
    bf16 *xb = (bf16*)(ws + WS_A), *x2 = (bf16*)(ws + WS_A), *Hb = (bf16*)(ws + WS_B), *x1 = (bf16*)(ws + WS_C), *x3b = (bf16*)(ws + WS_C), *Ob = (bf16*)(ws + WS_D), *cat = (bf16*)(ws + WS_E);
    bf16 *qb = (bf16*)(ws + WS_B), *kb = qb + (size_t)M * 512, *vb = kb + (size_t)M * 512, *ub = vb + (size_t)M * 512;
    const int lo = args.ph_lo, hi = args.ph_hi;
    volatile LAS unsigned* bst = (volatile LAS unsigned*)(L + MISC_OFF);
    if (tid < 4) bst[tid] = 0u;
    __syncthreads();
    XcdBarrier bar; bar.bar = (unsigned*)(ws + WS_BAR); bar.x = 0; bar.st = bst;
    if (hi - lo > 1) bar = xcd_barrier_post((unsigned*)(ws + WS_BAR), bst);
    if (hi > 1000) cg::this_grid().sync();
#define IN(k) (lo <= (k) && (k) < hi)
#define SEAM(k) do { if (IN(k) && IN((k) + 1)) xcd_barrier(bar); } while (0)

    if (IN(0)) {
        LAS float* scr = (LAS float*)(L + wave * 16384);
        constexpr int I_GU = 16 * 176, I_D = 44 * 32, I_IN = 16 * 64, I_OUT = 8 * 32, NITEMS = 2 * (I_GU + I_D) + I_IN + I_OUT;
        for (int it = gw; it < NITEMS; it += NGW) {
            int r = it;
            if (r < 2 * I_GU) { const int l2 = r >= I_GU; r -= l2 * I_GU; const int kbk = r / 176, nb = r % 176, n0 = 32 * nb, half = (n0 >> 7) & 1, scol0 = 128 * (n0 >> 8) + (n0 & 127);
                const float* W = l2 ? (half ? args.in[17] : args.in[16]) : (half ? args.in[3] : args.in[2]);
                p0_tr_item(W, FF, scol0, l2 ? args.in[15] : args.in[1], 64 * kbk, l2 ? Wgu2 : Wgu1, DM, n0, scr, lane); continue; }
            r -= 2 * I_GU;
            if (r < 2 * I_D) { const int l2 = r >= I_D; r -= l2 * I_D; const int kbk = r / 32, nb = r % 32;
                if (l2) p0_tr_item_f8(args.in[18], DM, 32 * nb, pg8::W8_SCALE, 64 * kbk, (unsigned char*)Wd2, FF, 32 * nb, scr, lane);
                else p0_tr_item(args.in[4], DM, 32 * nb, nullptr, 64 * kbk, Wd1, FF, 32 * nb, scr, lane);
                continue; }
            r -= 2 * I_D;
            if (r < I_IN) { const int kbk = r / 64, nb = r % 64, n0 = 32 * nb; const int scol0 = n0 < 1024 ? ((n0 >> 8) * 256 + 64 * ((n0 >> 5) & 3) + 32 * ((n0 >> 7) & 1)) : n0;
                p0_tr_item(args.in[6], NIN, scol0, args.in[5], 64 * kbk, Win, DM, n0, scr, lane); continue; }
            r -= I_IN;
            { const int kbk = r / 32, nb = r % 32; p0_tr_item(args.in[14], DM, 32 * nb, nullptr, 64 * kbk, Wout, DM, 32 * nb, scr, lane); }
        }
        const int gtid = gw * 64 + lane, NT = NGW * 64;
        for (int it = gw; it < 16 * 128; it += NGW) { const int n = (it & 15) * 64 + lane, k0 = (it >> 4) * 4, g = k0 >> 7, kk = k0 & 127;
            const float* pw = args.in[12] + ((size_t)g * 128 + kk) * 128; const float* sc = args.in[13] + g * 128; const float* wo = args.in[14] + (size_t)(512 + g * 128) * DM + n;
            float acc4[4] = {0.f, 0.f, 0.f, 0.f};
#pragma unroll 16
            for (int j = 0; j < 128; ++j) { const float w = wo[(size_t)j * DM] * sc[j];
#pragma unroll
                for (int e = 0; e < 4; ++e) acc4[e] += pw[e * 128 + j] * w; }
            *(unsigned long long*)(Wout + (size_t)n * DM + 512 + k0) = (unsigned long long)pk2(acc4[0], acc4[1]) | ((unsigned long long)pk2(acc4[2], acc4[3]) << 32); }
        for (int idx = gtid; idx < SEQL * 32; idx += NT) { const int pos = idx >> 5, j = idx & 31;
            const float pw = (float)pow(10000.0, (double)j * (1.0 / 32.0)); const float inv = 1.0f / pw; const float ang = (float)pos * inv;
            const double a = (double)ang, nq = rint(a * 0.63661977236758134308); double r = fma(-nq, 1.57079632679489655800, a); r = fma(-nq, 6.12323399573676603587e-17, r);
            const double r2 = r * r;
            const double sn = r * (1.0 + r2 * (-1.0 / 6 + r2 * (1.0 / 120 + r2 * (-1.0 / 5040 + r2 * (1.0 / 362880 + r2 * (-1.0 / 39916800 + r2 * (1.0 / 6227020800.0)))))));
            const double cs = 1.0 + r2 * (-0.5 + r2 * (1.0 / 24 + r2 * (-1.0 / 720 + r2 * (1.0 / 40320 + r2 * (-1.0 / 3628800 + r2 * (1.0 / 479001600.0 + r2 * (-1.0 / 87178291200.0)))))));
            const int qd = ((int)nq) & 3; const double c = (qd == 0) ? cs : (qd == 1) ? -sn : (qd == 2) ? -cs : sn, s = (qd == 0) ? sn : (qd == 1) ? cs : (qd == 2) ? -sn : -cs;
            *(float2*)(cst + (size_t)idx * 2) = make_float2((float)c, (float)s); }
        for (int idx = gtid; idx < 3 * M / 4; idx += NT) ((f32x4*)(ssq0 + M))[idx] = (f32x4){0.f, 0.f, 0.f, 0.f};
        for (int ch = gw; ch < M / 32; ch += NGW)
#pragma unroll 1
            for (int rr = 0; rr < 32; rr += 4) { const int row = ch * 32 + rr; const f32x4* __restrict__ xr = (const f32x4*)(x + (size_t)row * DM) + lane; f32x4 v[4][4];
#pragma unroll
                for (int q = 0; q < 4; ++q)
#pragma unroll
                    for (int j = 0; j < 4; ++j) v[q][j] = __builtin_nontemporal_load(xr + q * 256 + 64 * j);
#pragma unroll
                for (int q = 0; q < 4; ++q) { float s = 0.f;
#pragma unroll
                    for (int j = 0; j < 4; ++j) s += (v[q][j].x * v[q][j].x + v[q][j].y * v[q][j].y) + (v[q][j].z * v[q][j].z + v[q][j].w * v[q][j].w);
                    s = wave_sum(s); if (lane == 0) ssq0[row + q] = s;
                    unsigned long long* __restrict__ o8 = (unsigned long long*)(xb + (size_t)(row + q) * DM) + lane;
#pragma unroll
                    for (int j = 0; j < 4; ++j) o8[64 * j] = (unsigned long long)pk2(v[q][j].x, v[q][j].y) | ((unsigned long long)pk2(v[q][j].z, v[q][j].w) << 32); } }
    }
    SEAM(0);
    if (IN(1)) { pg8::Gemm g{xb, Wgu1, M, 2 * FF, DM}; pg8::StaticOrder S; S.init(M, 2 * FF, G, bx); pg8::EpiSwiglu<false> E{Hb, ssq0};
        pg8::gemm_phase<pg8::EpiSwiglu<false>, pg8::StaticOrder, true, false>(L, g, S, E); }
    SEAM(1);
    if (IN(2)) { pg8::Gemm g{Hb, Wd1, M, DM, FF}; pg8::StaticOrder S; S.init(M, DM, G, bx); pg8::EpiRes<false> E{xb, x1, ssq1, 0.5f};
        pg8::gemm_phase<pg8::EpiRes<false>, pg8::StaticOrder, true, false>(L, g, S, E); }
    SEAM(2);
    if (IN(3)) { pg8::Gemm g{x1, Win, M, NIN, DM}; pg8::StaticOrder S; S.init(M, NIN, G, bx); pg8::EpiWin E{qb, kb, vb, ub, ssq1, cst, attn_body::C2};
        pg8::gemm_phase<pg8::EpiWin, pg8::StaticOrder, true, false>(L, g, S, E); }
    SEAM(3);
    if (IN(4)) {
        { const float s1 = wave_sum(args.in[7][lane] * args.in[8][lane]), s2 = wave_sum(args.in[9][lane] * args.in[10][lane]);
          const float lam = expf(s1) - expf(s2) + 0.2f;
          attn2::attn_phase<8>((char*)lds, vcu, (const attn_body::bf16*)qb, (const attn_body::bf16*)kb, (const attn_body::bf16*)vb, (attn_body::bf16*)cat, lam, args.in[11]); }
        for (int ch = gw; ch < M / 32; ch += NGW) {
            const int row0 = ch * 32, t0 = row0 & (SEQL - 1), win = 2 << (lane >> 4);
            const bf16* __restrict__ up = ub + (size_t)row0 * 512 + lane * 8; bf16* __restrict__ dp = cat + (size_t)row0 * 1024 + 512 + lane * 8;
            float S[8];
#pragma unroll
            for (int e = 0; e < 8; ++e) S[e] = 0.f;
            { v4u pv[15];
#pragma unroll
              for (int i = 1; i < 16; ++i) { const bool ok = (i < win) && (t0 >= i); pv[i - 1] = *(const v4u*)(up - (ok ? (size_t)i * 512 : 0)); }
#pragma unroll
              for (int i = 1; i < 16; ++i) { const float wgt = ((i < win) && (t0 >= i)) ? 1.f : 0.f; const v4u w = pv[i - 1];
                  S[0] += wgt * bflo(w.x); S[1] += wgt * bfhi(w.x); S[2] += wgt * bflo(w.y); S[3] += wgt * bfhi(w.y); S[4] += wgt * bflo(w.z); S[5] += wgt * bfhi(w.z); S[6] += wgt * bflo(w.w); S[7] += wgt * bfhi(w.w); } }
#pragma unroll 1
            for (int c8 = 0; c8 < 4; ++c8) { v4u nw[8], od[8];
#pragma unroll
                for (int j = 0; j < 8; ++j) { const int r = c8 * 8 + j, ro = r + 1 - win; nw[j] = *(const v4u*)(up + (size_t)r * 512); od[j] = *(const v4u*)(up + ((t0 + ro >= 0) ? (long)ro * 512 : 0)); }
#pragma unroll
                for (int j = 0; j < 8; ++j) { const int r = c8 * 8 + j, t = t0 + r, cnt = (t + 1 < win) ? t + 1 : win; const float ic = 1.0f / (float)cnt, wo = (t + 1 - win >= 0) ? 1.f : 0.f;
                    const v4u w = nw[j], q = od[j];
                    const float nf[8] = {bflo(w.x), bfhi(w.x), bflo(w.y), bfhi(w.y), bflo(w.z), bfhi(w.z), bflo(w.w), bfhi(w.w)}, of[8] = {bflo(q.x), bfhi(q.x), bflo(q.y), bfhi(q.y), bflo(q.z), bfhi(q.z), bflo(q.w), bfhi(q.w)};
                    float d[8];
#pragma unroll
                    for (int e = 0; e < 8; ++e) { const float sf = S[e] + nf[e]; d[e] = sf * ic - nf[e]; S[e] = sf - wo * of[e]; }
                    v4u o; o.x = pk2(d[0], d[1]); o.y = pk2(d[2], d[3]); o.z = pk2(d[4], d[5]); o.w = pk2(d[6], d[7]);
                    *(v4u*)(dp + (size_t)r * 1024) = o; } }
        }
    }
    SEAM(4);
    if (IN(6)) { pg8::Gemm g{cat, Wout, M, DM, DM}; pg8::StaticOrder S; S.init(M, DM, G, bx); pg8::EpiRes<false> E{x1, x2, ssq2, 1.0f};
        pg8::gemm_phase<pg8::EpiRes<false>, pg8::StaticOrder, true, false>(L, g, S, E); }
    SEAM(6);
    if (IN(7)) { pg8::Gemm g{x2, Wgu2, M, 2 * FF, DM}; pg8::StaticOrder S; S.init(M, 2 * FF, G, bx); pg8::EpiSwiglu<true> E{Hb, ssq2};
        pg8::gemm_phase<pg8::EpiSwiglu<true>, pg8::StaticOrder, true, false>(L, g, S, E); }
    SEAM(7);
    if (IN(8)) { pg8::Gemm g{Hb, Wd2, M, DM, FF / 2}; pg8::StaticOrder S; S.init(M, DM, G, bx); pg8::EpiRes<false> E{x2, x3b, ssq3, 0.5f / (pg8::H8_SCALE * pg8::W8_SCALE)};
        pg8::gemm_phase<pg8::EpiRes<false>, pg8::StaticOrder, true, false, true>(L, g, S, E); }
    SEAM(8);
    if (IN(9)) {
        f32x4 gv[4];
#pragma unroll
        for (int j = 0; j < 4; ++j) gv[j] = *(const f32x4*)(args.in[19] + (j >> 1) * 512 + lane * 8 + (j & 1) * 4);
        for (int ch = gw; ch < M / 32; ch += NGW)
#pragma unroll 1
            for (int rr = 0; rr < 32; rr += 8) { const int row = ch * 32 + rr; v4u v[8][2]; float rs[8];
#pragma unroll
                for (int q = 0; q < 8; ++q) { rs[q] = pg8::rstd_of(ssq3[row + q]); const bf16* xr = x3b + (size_t)(row + q) * DM + lane * 8; v[q][0] = *(const v4u*)xr; v[q][1] = *(const v4u*)(xr + 512); }
#pragma unroll
                for (int q = 0; q < 8; ++q) { float* orow = args.out + (size_t)(row + q) * DM + lane * 8;
#pragma unroll
                    for (int hf = 0; hf < 2; ++hf) { const v4u w = v[q][hf];
                        *(f32x4*)(orow + hf * 512) = (f32x4){bflo(w.x), bfhi(w.x), bflo(w.y), bfhi(w.y)} * rs[q] * gv[2 * hf];
                        *(f32x4*)(orow + hf * 512 + 4) = (f32x4){bflo(w.z), bfhi(w.z), bflo(w.w), bfhi(w.w)} * rs[q] * gv[2 * hf + 1]; } } }
    }
#undef IN
#undef SEAM
}

extern "C" void kernel_launch(void* const* d_in, const int* in_sizes, int n_in, void* d_out, int out_size, void* d_ws, size_t ws_size, hipStream_t stream) {
    static int grid = 0;
    if (grid == 0) {
        if (n_in != 20 || in_sizes[0] != M * DM || out_size != M * DM || ws_size < WS_END) { fprintf(stderr, "kernel_launch: unexpected shapes (n_in %d, in0 %d, out %d, ws %zu); nothing launched\n", n_in, n_in > 0 ? in_sizes[0] : -1, out_size, ws_size); grid = -1; return; }
        int dev = 0, cus = 0, per_cu = 0;
        if (hipGetDevice(&dev) != hipSuccess || hipDeviceGetAttribute(&cus, hipDeviceAttributeMultiprocessorCount, dev) != hipSuccess) { grid = -1; return; }
        if (hipFuncSetAttribute((const void*)mk_fwd, hipFuncAttributeMaxDynamicSharedMemorySize, LDS_BYTES) != hipSuccess) { fprintf(stderr, "kernel_launch: hipFuncSetAttribute failed\n"); grid = -1; return; }
        if (hipOccupancyMaxActiveBlocksPerMultiprocessor(&per_cu, (const void*)mk_fwd, NWAVES * 64, LDS_BYTES) != hipSuccess || per_cu < 1) { fprintf(stderr, "kernel_launch: occupancy query says %d\n", per_cu); per_cu = 1; }
        (void)hipGetLastError();
        grid = cus * per_cu;
    }
    if (grid < 0) return;
    Args a{};
    for (int i = 0; i < 20; ++i) a.in[i] = (const float*)d_in[i];
    a.out = (float*)d_out; a.ws = (unsigned char*)d_ws;
#if MK_N_LAUNCHES == 1
    a.ph_lo = 0; a.ph_hi = NPH;
    (void)hipMemsetAsync((char*)d_ws + WS_BAR, 0, XCD_BAR_WORDS * 4, stream);
    void* params[] = {&a};
    const hipError_t e = hipLaunchCooperativeKernel((const void*)mk_fwd, dim3(grid), dim3(NWAVES * 64), params, LDS_BYTES, stream);
    if (e != hipSuccess) fprintf(stderr, "kernel_launch: cooperative launch failed: %s (grid %d)\n", hipGetErrorString(e), grid);
#else
#ifndef MK_PROBE_MASK
#define MK_PROBE_MASK 0
#endif
    for (int p = 0; p < NPH; ++p) { a.ph_lo = p; a.ph_hi = p + 1;
        if ((MK_PROBE_MASK >> p) & 1) { a.dummy = 1; hipLaunchKernelGGL(mk_fwd, dim3(grid), dim3(NWAVES * 64), LDS_BYTES, stream, a); a.dummy = 0; }
        hipLaunchKernelGGL(mk_fwd, dim3(grid), dim3(NWAVES * 64), LDS_BYTES, stream, a); }
#endif
}
```

```cpp
#define MK_N_LAUNCHES 1
#define MK_PROBE_MASK 0
#include <hip/hip_runtime.h>
#include <cstdio>
#include <cstdint>
namespace pg8 {
#define PG8_LAS __attribute__((address_space(3)))
typedef unsigned short bf16_t;
typedef short bf16x8 __attribute__((ext_vector_type(8)));
typedef float f32x4 __attribute__((ext_vector_type(4)));
typedef unsigned u32x4 __attribute__((ext_vector_type(4)));
constexpr int BM = 256, BK = 64, HALF = 128, HTB = HALF * BK * 2  , STAGE_BYTES = 8 * HTB, NXCD = 8, WGM = 8;

__host__ __device__ __forceinline__ int lds_byte(int r, int c) { const int st = (r >> 4) * 2 + (c >> 5), rr = r & 15, cc = c & 31, ob = rr * 64 + cc * 2; return st * 1024 + (ob ^ (((ob >> 9) & 1) << 5)); }
__host__ __device__ __forceinline__ void stage_rc(int b, int& R, int& C) { const int st = b / 1024, sb = b % 1024, swz = sb ^ (((sb >> 9) & 1) << 5); R = (st >> 1) * 16 + swz / 64; C = (st & 1) * 32 + (swz % 64) / 2; }
__host__ __device__ __forceinline__ int perm32(int rho) { const int n = rho >> 4, i = rho & 15; return 8 * (i >> 2) + 4 * n + (i & 3); }

struct Unit { int pm, pn; };
struct Gemm { const bf16_t* A; const bf16_t* Bt; int M, N, K; };

struct StaticOrder {
    int nM, nN, nwg, G, c;
    __host__ __device__ void init(int M, int N, int G_, int c_) { nM = M / BM; nN = N / BM; nwg = nM * nN; G = G_; c = c_; }
    __host__ __device__ bool next(int i, Unit& u) const {
        const long L = (long)i * G + c; if (L >= nwg) return false;
        int wgid = (int)L; { const int q = nwg / NXCD, r = nwg % NXCD, xcd = wgid % NXCD, off = wgid / NXCD; wgid = (xcd < r ? xcd * (q + 1) : r * (q + 1) + (xcd - r) * q) + off; }
        const int nig = WGM * nN, gid = wgid / nig, fm = gid * WGM, gsz = (nM - fm) < WGM ? (nM - fm) : WGM;
        u.pm = fm + ((wgid % nig) % gsz); u.pn = (wgid % nig) / gsz; return true;
    }
    __device__ __forceinline__ void a_ready(const Unit&) const {}
    __device__ __forceinline__ void done(const Unit&) const {}
};


__device__ __forceinline__ unsigned cvt_pk_bf16(float lo, float hi) { unsigned r; asm("v_cvt_pk_bf16_f32 %0, %1, %2" : "=v"(r) : "v"(lo), "v"(hi)); return r; }
__device__ __forceinline__ u32x4 pack8(const f32x4 a, const f32x4 b) { u32x4 w; w.x = cvt_pk_bf16(a[0], a[1]); w.y = cvt_pk_bf16(a[2], a[3]); w.z = cvt_pk_bf16(b[0], b[1]); w.w = cvt_pk_bf16(b[2], b[3]); return w; }
__device__ __forceinline__ void unpack8(const u32x4 w, f32x4& a, f32x4& b) {
    a[0] = __uint_as_float(w.x << 16); a[1] = __uint_as_float(w.x & 0xffff0000u); a[2] = __uint_as_float(w.y << 16); a[3] = __uint_as_float(w.y & 0xffff0000u);
    b[0] = __uint_as_float(w.z << 16); b[1] = __uint_as_float(w.z & 0xffff0000u); b[2] = __uint_as_float(w.w << 16); b[3] = __uint_as_float(w.w & 0xffff0000u); }
constexpr float RMS_EPS = 1e-6f;
__device__ __forceinline__ float rstd_of(float ssq) { return __builtin_amdgcn_rsqf(ssq * (1.0f / 1024.0f) + RMS_EPS); }

struct EpiPlain {
    static constexpr bool PERM = true, AFTER_DRAIN = false;
    bf16_t* O; int ldc; int coff;
    __device__ __forceinline__ void prefetch(float (&)[8], const Unit&, int, int) const {}
    __device__ __forceinline__ void operator()(const f32x4 (&acc)[2][2][4][2], const Unit& u, int wr, int wc, int fr, int fq, const float (&)[8]) const {
        const int row0 = u.pm * BM + wr * 64 + fr, col0 = coff + u.pn * BM + wc * 32 + 8 * fq;
#pragma unroll
        for (int ai = 0; ai < 2; ++ai)
#pragma unroll
            for (int m = 0; m < 4; ++m) { bf16_t* rowp = O + (size_t)(row0 + ai * HALF + m * 16) * ldc + col0;
#pragma unroll
                for (int bj = 0; bj < 2; ++bj) *(u32x4*)(rowp + bj * HALF) = pack8(acc[ai][bj][m][0], acc[ai][bj][m][1]); }
    }
};
constexpr float H8_SCALE = 8.0f, W8_SCALE = 64.0f;
__device__ __forceinline__ unsigned pk4_fp8(float a, float b, float c, float d) {
    a = __builtin_fminf(__builtin_fmaxf(a, -448.f), 448.f); b = __builtin_fminf(__builtin_fmaxf(b, -448.f), 448.f); c = __builtin_fminf(__builtin_fmaxf(c, -448.f), 448.f); d = __builtin_fminf(__builtin_fmaxf(d, -448.f), 448.f);
    unsigned w = 0u; w = __builtin_amdgcn_cvt_pk_fp8_f32(a, b, w, false); w = __builtin_amdgcn_cvt_pk_fp8_f32(c, d, w, true); return w; }
template <bool F8OUT> struct EpiSwiglu {
    static constexpr bool PERM = true, AFTER_DRAIN = false;
    bf16_t* O; const float* ssq;
    __device__ __forceinline__ void prefetch(float (&pre)[8], const Unit& u, int wr, int fr) const {
#pragma unroll
        for (int i = 0; i < 8; ++i) pre[i] = ssq[u.pm * BM + wr * 64 + fr + (i >> 2) * HALF + (i & 3) * 16]; }
    __device__ __forceinline__ void operator()(const f32x4 (&acc)[2][2][4][2], const Unit& u, int wr, int wc, int fr, int fq, const float (&pre)[8]) const {
        typedef float f32x2 __attribute__((ext_vector_type(2)));
        const int row0 = u.pm * BM + wr * 64 + fr, col0 = u.pn * HALF + wc * 32 + 8 * fq;
#pragma unroll
        for (int ai = 0; ai < 2; ++ai)
#pragma unroll
            for (int m = 0; m < 4; ++m) { const int row = row0 + ai * HALF + m * 16; const float rs = rstd_of(pre[ai * 4 + m]), nrl = rs * -1.4426950408889634f, rs2 = rs * rs;
                f32x4 o[2];
#pragma unroll
                for (int n = 0; n < 2; ++n)
#pragma unroll
                    for (int e = 0; e < 4; e += 2) { const f32x2 g = (f32x2){acc[ai][0][m][n][e], acc[ai][0][m][n][e + 1]}, up = (f32x2){acc[ai][1][m][n][e], acc[ai][1][m][n][e + 1]};
                        const f32x2 t = g * nrl; f32x2 d; d.x = __builtin_amdgcn_exp2f(t.x); d.y = __builtin_amdgcn_exp2f(t.y); d = d + 1.0f;
                        f32x2 sg; sg.x = __builtin_amdgcn_rcpf(d.x); sg.y = __builtin_amdgcn_rcpf(d.y);
                        const f32x2 r = ((g * up) * rs2) * sg; o[n][e] = r.x; o[n][e + 1] = r.y; }
                if constexpr (F8OUT) { typedef unsigned u32x2_ __attribute__((ext_vector_type(2))); const f32x4 s0 = o[0] * H8_SCALE, s1 = o[1] * H8_SCALE;
                    *(u32x2_*)((unsigned char*)O + (size_t)row * 2816 + col0) = (u32x2_){pk4_fp8(s0[0], s0[1], s0[2], s0[3]), pk4_fp8(s1[0], s1[1], s1[2], s1[3])}; }
                else { u32x4 w = pack8(o[0], o[1]); w = (w + 0x00020002u) & 0xfffcfffcu; *(u32x4*)(O + (size_t)row * 2816 + col0) = w; } }
    }
};
template <bool OUTF32> struct EpiRes {
    static constexpr bool PERM = true, AFTER_DRAIN = false;
    const bf16_t* res; void* out; float* ssq; float alpha;
    __device__ __forceinline__ void prefetch(float (&)[8], const Unit&, int, int) const {}
    __device__ __forceinline__ void operator()(const f32x4 (&acc)[2][2][4][2], const Unit& u, int wr, int wc, int fr, int fq, const float (&)[8]) const {
        const int row0 = u.pm * BM + wr * 64 + fr, col0 = u.pn * BM + wc * 32 + 8 * fq;
        u32x4 rr[2][4][2];
#pragma unroll
        for (int ai = 0; ai < 2; ++ai)
#pragma unroll
            for (int m = 0; m < 4; ++m)
#pragma unroll
                for (int bj = 0; bj < 2; ++bj) rr[ai][m][bj] = *(const u32x4*)(res + (size_t)(row0 + ai * HALF + m * 16) * 1024 + col0 + bj * HALF);
        asm volatile("" ::: "memory");
#pragma unroll
        for (int ai = 0; ai < 2; ++ai)
#pragma unroll
            for (int m = 0; m < 4; ++m) { const int row = row0 + ai * HALF + m * 16; const size_t off = (size_t)row * 1024 + col0; float s = 0.f;
#pragma unroll
                for (int bj = 0; bj < 2; ++bj) { f32x4 r0, r1; unpack8(rr[ai][m][bj], r0, r1);
                    const f32x4 v0 = r0 + acc[ai][bj][m][0] * alpha, v1 = r1 + acc[ai][bj][m][1] * alpha;
                    s += (v0[0] * v0[0] + v0[1] * v0[1]) + (v0[2] * v0[2] + v0[3] * v0[3]) + (v1[0] * v1[0] + v1[1] * v1[1]) + (v1[2] * v1[2] + v1[3] * v1[3]);
                    if (OUTF32) { *(f32x4*)((float*)out + off + bj * HALF) = v0; *(f32x4*)((float*)out + off + bj * HALF + 4) = v1; }
                    else { *(u32x4*)((bf16_t*)out + off + bj * HALF) = pack8(v0, v1); } }
                s += __shfl_xor(s, 16); s += __shfl_xor(s, 32);
                if (fq == 0) __hip_atomic_fetch_add(ssq + row, s, __ATOMIC_RELAXED, __HIP_MEMORY_SCOPE_AGENT); }
    }
};
struct EpiWin {
    static constexpr bool PERM = true, AFTER_DRAIN = false;
    bf16_t *q, *k, *v, *uu; const float* ssq; const float* cst; float qscale;
    __device__ __forceinline__ void prefetch(float (&pre)[8], const Unit& u, int wr, int fr) const {
#pragma unroll
        for (int i = 0; i < 8; ++i) pre[i] = ssq[u.pm * BM + wr * 64 + fr + (i >> 2) * HALF + (i & 3) * 16]; }
    __device__ __forceinline__ void operator()(const f32x4 (&acc)[2][2][4][2], const Unit& u, int wr, int wc, int fr, int fq, const float (&pre)[8]) const {
        const int row0 = u.pm * BM + wr * 64 + fr, pn = u.pn;
        if (pn < 4) {
            bf16_t* dst = (pn < 2) ? q : k; const float sc = (pn < 2) ? qscale : 1.0f; const int colb = (pn & 1) * 256 + 64 * wc + 8 * fq;
#pragma unroll
            for (int ai = 0; ai < 2; ++ai)
#pragma unroll
                for (int m = 0; m < 4; ++m) { const int row = row0 + ai * HALF + m * 16; const float rs = rstd_of(pre[ai * 4 + m]) * sc; const int pos = row & 8191;
                    const f32x4* t4 = (const f32x4*)(cst + ((size_t)pos * 32 + 8 * fq) * 2);
                    f32x4 o1[2], o2[2];
#pragma unroll
                    for (int n = 0; n < 2; ++n) { const f32x4 ta = t4[2 * n], tb = t4[2 * n + 1]; const f32x4 x1 = acc[ai][0][m][n] * rs, x2 = acc[ai][1][m][n] * rs;
                        o1[n][0] = x1[0] * ta[0] - x2[0] * ta[1]; o2[n][0] = x1[0] * ta[1] + x2[0] * ta[0];
                        o1[n][1] = x1[1] * ta[2] - x2[1] * ta[3]; o2[n][1] = x1[1] * ta[3] + x2[1] * ta[2];
                        o1[n][2] = x1[2] * tb[0] - x2[2] * tb[1]; o2[n][2] = x1[2] * tb[1] + x2[2] * tb[0];
                        o1[n][3] = x1[3] * tb[2] - x2[3] * tb[3]; o2[n][3] = x1[3] * tb[3] + x2[3] * tb[2]; }
                    bf16_t* rowp = dst + (size_t)row * 512 + colb;
                    *(u32x4*)(rowp) = pack8(o1[0], o1[1]); *(u32x4*)(rowp + 32) = pack8(o2[0], o2[1]);
                    if (m & 1) asm volatile("" ::: "memory"); }
        } else {
            bf16_t* dst = (pn < 6) ? v : uu; const int colb = (pn & 1) * 256 + wc * 32 + 8 * fq;
#pragma unroll
            for (int ai = 0; ai < 2; ++ai)
#pragma unroll
                for (int m = 0; m < 4; ++m) { const int row = row0 + ai * HALF + m * 16; const float rs = rstd_of(pre[ai * 4 + m]); bf16_t* rowp = dst + (size_t)row * 512 + colb;
#pragma unroll
                    for (int bj = 0; bj < 2; ++bj) *(u32x4*)(rowp + bj * HALF) = pack8(acc[ai][bj][m][0] * rs, acc[ai][bj][m][1] * rs); }
        }
    }
};

template <class Epi, class Sched, bool ALIGN_EPI = false, bool SP2 = false, bool F8 = false>
__device__ __forceinline__ void gemm_phase(PG8_LAS unsigned char* lds, const Gemm g, const Sched& S, const Epi& E) {
    const int tid = threadIdx.x, wid = __builtin_amdgcn_readfirstlane(tid >> 6), lane = tid & 63, wr = wid >> 2, wc = wid & 3, fr = lane & 15, fq = lane >> 4;
    const int K = g.K, nt = K / BK;
    unsigned voffA[2], voffB[2];
#pragma unroll
    for (int i = 0; i < 2; ++i) { int R, C; stage_rc(tid * 16 + i * 8192, R, C); const int Rb = Epi::PERM ? ((R & ~31) + perm32(R & 31)) : R;
        voffA[i] = (unsigned)(R * K + C) * 2u; voffB[i] = (unsigned)(Rb * K + C) * 2u; }
    const size_t kstep = (size_t)(BK * 2);
    const size_t hstep = (size_t)HALF * K * 2;
    const size_t tstep = 2 * hstep;
    const unsigned ldsw = (unsigned)wid * 1024u;
    const int aoff = lds_byte(wr * 64 + fr, fq * 8), boff = lds_byte(wc * 32 + fr, fq * 8);
#define PG8_SA(b, h) (((b) * 2 + (h)) * HTB)
#define PG8_SB(b, h) ((4 + (b) * 2 + (h)) * HTB)
#define PG8_STAGE(bufoff, gbase, voff) do { _Pragma("unroll") for (int _i = 0; _i < 2; ++_i) \
        __builtin_amdgcn_global_load_lds((const unsigned*)((const char*)(gbase) + (voff)[_i]), (PG8_LAS unsigned*)(lds + (bufoff) + ldsw + _i * 8192), 16, 0, 0); } while (0)
#define PG8_LDA(dst, b, h) do { _Pragma("unroll") for (int m = 0; m < 4; ++m) _Pragma("unroll") for (int k = 0; k < 2; ++k) dst[m][k] = *(const PG8_LAS bf16x8*)(lds + PG8_SA(b, h) + aoff + m * 2048 + k * 1024); } while (0)
#define PG8_LDB(dst, b, h) do { _Pragma("unroll") for (int n = 0; n < 2; ++n) _Pragma("unroll") for (int k = 0; k < 2; ++k) dst[n][k] = *(const PG8_LAS bf16x8*)(lds + PG8_SB(b, h) + boff + n * 2048 + k * 1024); } while (0)
#define PG8_MMA(ai, bj, At, Bt) do { __builtin_amdgcn_s_setprio(1); _Pragma("unroll") for (int m = 0; m < 4; ++m) _Pragma("unroll") for (int n = 0; n < 2; ++n) { \
        if constexpr (F8) { typedef int v4i_ __attribute__((ext_vector_type(4))); typedef int v8i_ __attribute__((ext_vector_type(8))); \
            const v8i_ a8 = __builtin_shufflevector(__builtin_bit_cast(v4i_, At[m][0]), __builtin_bit_cast(v4i_, At[m][1]), 0, 1, 2, 3, 4, 5, 6, 7), b8 = __builtin_shufflevector(__builtin_bit_cast(v4i_, Bt[n][0]), __builtin_bit_cast(v4i_, Bt[n][1]), 0, 1, 2, 3, 4, 5, 6, 7); \
            asm("v_mfma_f32_16x16x128_f8f6f4 %0, %1, %2, %0" : "+v"(acc[ai][bj][m][n]) : "v"(b8), "v"(a8)); } \
        else { _Pragma("unroll") for (int k = 0; k < 2; ++k) acc[ai][bj][m][n] = __builtin_amdgcn_mfma_f32_16x16x32_bf16(Bt[n][k], At[m][k], acc[ai][bj][m][n], 0, 0, 0); } } \
        __builtin_amdgcn_s_setprio(0); } while (0)
#define PG8_WAIT_V(n) asm volatile("s_waitcnt vmcnt(" #n ")" ::: "memory")
#define PG8_WAIT_L(n) asm volatile("s_waitcnt lgkmcnt(" #n ")" ::: "memory")
#define PG8_BAR __builtin_amdgcn_s_barrier()
#define PG8_SCHED __builtin_amdgcn_sched_barrier(0)
    Unit cur, nxt; int ui = 0;
    if (!S.next(0, cur)) return;
    f32x4 acc[2][2][4][2];
    float pre[8];
#pragma unroll
    for (int i = 0; i < 8; ++i) pre[i] = 0.f;
#pragma unroll
    for (int a = 0; a < 2; ++a)
#pragma unroll
        for (int b = 0; b < 2; ++b)
#pragma unroll
            for (int m = 0; m < 4; ++m)
#pragma unroll
                for (int n = 0; n < 2; ++n) acc[a][b][m][n] = (f32x4){0.f, 0.f, 0.f, 0.f};
    bf16x8 At[4][2], B0[2][2], B1[2][2];
    const char* cA = (const char*)g.A + (size_t)cur.pm * tstep; const char* cB = (const char*)g.Bt + (size_t)cur.pn * tstep;
    S.a_ready(cur);
    if constexpr (SP2) {
        PG8_STAGE(PG8_SB(0, 0), cB, voffB); PG8_STAGE(PG8_SB(0, 1), cB + hstep, voffB); PG8_STAGE(PG8_SA(0, 0), cA, voffA); PG8_STAGE(PG8_SA(0, 1), cA + hstep, voffA);
        if (wr == 1) PG8_BAR;
        PG8_WAIT_V(2); PG8_BAR;
        PG8_STAGE(PG8_SB(1, 0), cB + kstep, voffB); PG8_STAGE(PG8_SA(1, 0), cA + kstep, voffA); PG8_STAGE(PG8_SB(1, 1), cB + hstep + kstep, voffB);
        PG8_WAIT_V(6); PG8_BAR;
    } else {
        PG8_STAGE(PG8_SB(0, 0), cB, voffB); PG8_STAGE(PG8_SA(0, 0), cA, voffA); PG8_STAGE(PG8_SB(0, 1), cB + hstep, voffB); PG8_STAGE(PG8_SA(0, 1), cA + hstep, voffA);
        if (wr == 1) PG8_BAR;
        PG8_WAIT_V(4); PG8_BAR;
        PG8_STAGE(PG8_SB(1, 0), cB + kstep, voffB); PG8_STAGE(PG8_SA(1, 0), cA + kstep, voffA); PG8_STAGE(PG8_SB(1, 1), cB + hstep + kstep, voffB);
        PG8_WAIT_V(6); PG8_BAR;
    }
    for (;;) {
        const bool has_next = S.next(ui + 1, nxt);
        const char* nA = has_next ? (const char*)g.A + (size_t)nxt.pm * tstep : cA; const char* nB = has_next ? (const char*)g.Bt + (size_t)nxt.pn * tstep : cB;
        for (int t = 0; t < nt; t += 2) {
            const bool last = (t == nt - 2);
            const char* a1 = cA + (size_t)(t + 1) * kstep;
            const char* a2 = last ? nA : cA + (size_t)(t + 2) * kstep; const char* b2 = last ? nB : cB + (size_t)(t + 2) * kstep;
            const char* a3 = a2 + kstep; const char* b3 = b2 + kstep;
            if (last && has_next) S.a_ready(nxt);
            if (last) E.prefetch(pre, cur, wr, fr);
            if constexpr (SP2) {
            PG8_LDB(B0, 0, 0); PG8_LDB(B1, 0, 1); PG8_SCHED; PG8_LDA(At, 0, 0); PG8_STAGE(PG8_SA(1, 1), a1 + hstep, voffA);
            PG8_WAIT_V(8); PG8_WAIT_L(0); PG8_BAR; PG8_MMA(0, 0, At, B0); PG8_MMA(0, 1, At, B1); PG8_BAR; PG8_SCHED;
            PG8_LDA(At, 0, 1); PG8_STAGE(PG8_SB(0, 0), b2, voffB); PG8_STAGE(PG8_SB(0, 1), b2 + hstep, voffB); PG8_STAGE(PG8_SA(0, 0), a2, voffA);
            PG8_WAIT_V(8); PG8_WAIT_L(0); PG8_BAR; PG8_MMA(1, 0, At, B0); PG8_MMA(1, 1, At, B1); PG8_BAR; PG8_SCHED;
            PG8_LDB(B0, 1, 0); PG8_LDB(B1, 1, 1); PG8_SCHED; PG8_LDA(At, 1, 0); PG8_STAGE(PG8_SA(0, 1), a2 + hstep, voffA);
            PG8_WAIT_V(8); PG8_WAIT_L(0); PG8_BAR; PG8_MMA(0, 0, At, B0); PG8_MMA(0, 1, At, B1); PG8_BAR; PG8_SCHED;
            PG8_LDA(At, 1, 1); PG8_STAGE(PG8_SB(1, 0), b3, voffB); PG8_STAGE(PG8_SB(1, 1), b3 + hstep, voffB); PG8_STAGE(PG8_SA(1, 0), a3, voffA);
            PG8_WAIT_V(8); PG8_WAIT_L(0); PG8_BAR; PG8_MMA(1, 0, At, B0); PG8_MMA(1, 1, At, B1); PG8_BAR; PG8_SCHED;
            } else {
            PG8_LDB(B0, 0, 0); PG8_SCHED; PG8_LDA(At, 0, 0); PG8_STAGE(PG8_SA(1, 1), a1 + hstep, voffA);
            PG8_WAIT_L(8); PG8_BAR; PG8_WAIT_L(0); PG8_MMA(0, 0, At, B0); PG8_BAR; PG8_SCHED;
            PG8_LDB(B1, 0, 1); PG8_STAGE(PG8_SB(0, 0), b2, voffB);
            PG8_BAR; PG8_WAIT_L(0); PG8_MMA(0, 1, At, B1); PG8_BAR;
            PG8_LDA(At, 0, 1); PG8_STAGE(PG8_SA(0, 0), a2, voffA);
            PG8_BAR; PG8_WAIT_L(0); PG8_MMA(1, 0, At, B0); PG8_BAR; PG8_SCHED;
            PG8_STAGE(PG8_SB(0, 1), b2 + hstep, voffB);
            PG8_WAIT_V(6); PG8_BAR; PG8_MMA(1, 1, At, B1); PG8_BAR;
            PG8_LDB(B0, 1, 0); PG8_SCHED; PG8_LDA(At, 1, 0); PG8_STAGE(PG8_SA(0, 1), a2 + hstep, voffA);
            PG8_WAIT_L(8); PG8_BAR; PG8_WAIT_L(0); PG8_MMA(0, 0, At, B0); PG8_BAR; PG8_SCHED;
            PG8_LDB(B1, 1, 1); PG8_STAGE(PG8_SB(1, 0), b3, voffB);
            PG8_BAR; PG8_WAIT_L(0); PG8_MMA(0, 1, At, B1); PG8_BAR;
            PG8_LDA(At, 1, 1); PG8_STAGE(PG8_SA(1, 0), a3, voffA);
            PG8_BAR; PG8_WAIT_L(0); PG8_MMA(1, 0, At, B0); PG8_BAR; PG8_SCHED;
            PG8_STAGE(PG8_SB(1, 1), b3 + hstep, voffB);
            PG8_WAIT_V(6); PG8_BAR; PG8_MMA(1, 1, At, B1); PG8_BAR;
            }
        }
        if constexpr (F8) { asm volatile("s_nop 15\n\ts_nop 15" ::: "memory"); }
        if constexpr (ALIGN_EPI) { if (wr == 0) PG8_BAR; }
        if constexpr (!Epi::AFTER_DRAIN) { E(acc, cur, wr, wc, fr, fq, pre); S.done(cur); }
        if (!has_next) break;
#pragma unroll
        for (int a = 0; a < 2; ++a)
#pragma unroll
            for (int b = 0; b < 2; ++b)
#pragma unroll
                for (int m = 0; m < 4; ++m)
#pragma unroll
                    for (int n = 0; n < 2; ++n) acc[a][b][m][n] = (f32x4){0.f, 0.f, 0.f, 0.f};
        cur = nxt; cA = nA; cB = nB; ++ui;
        if constexpr (ALIGN_EPI) { if (wr == 1) PG8_BAR; }
    }
    PG8_WAIT_V(0);
    if constexpr (!ALIGN_EPI) { if (wr == 0) PG8_BAR; }
    PG8_BAR;
    if constexpr (Epi::AFTER_DRAIN) { E.fused(acc, cur, wr, wc, fr, fq, lds, wid, lane); S.done(cur); }
#undef PG8_SA
#undef PG8_SB
#undef PG8_STAGE
#undef PG8_LDA
#undef PG8_LDB
#undef PG8_MMA
#undef PG8_WAIT_V
#undef PG8_WAIT_L
#undef PG8_BAR
#undef PG8_SCHED
}
}
#include <hip/hip_bf16.h>
#include <cmath>
namespace attn_body {
using bf16=__hip_bfloat16;
using bf16x8=__attribute__((ext_vector_type(8)))short;
using s16x4=__attribute__((ext_vector_type(4)))short;
using f32x16=__attribute__((ext_vector_type(16)))float;
using u32x4=__attribute__((ext_vector_type(4)))unsigned;
constexpr int SEQ=8192,D=64,PQK=512,PV=512,PO=1024;
constexpr int NW=8,QBLK=32,QB=QBLK*NW,KVBLK=64,NQB=SEQ/QB;
constexpr int ATTN_UNIT_ROWS=QB;
__device__ __forceinline__ int crow(int r,int hi){return (r&3)+8*(r>>2)+4*hi;}
#define SBAR() __builtin_amdgcn_sched_barrier(0)
__device__ __forceinline__ void cmask(f32x16&p0,f32x16&p1,int jb,int qrel,int hi){
  const float NEG=-INFINITY; (void)hi;
  #pragma unroll
  for(int r=0;r<16;++r){ if(jb>(qrel>>6)){p0[r]=NEG; p1[r]=NEG;} }
}

constexpr int NSLOT=3, SLOTB=8192;
constexpr int LDS_K=0, LDS_V=NSLOT*SLOTB, LDS_WS=2*NSLOT*SLOTB, LDS_OST=LDS_WS+NW*64*4, LDS_BYTES=LDS_OST+NW*4096;
constexpr float C2=0.125f*1.4426950408889634f;
__device__ __forceinline__ void glds16(const void*gsrc,unsigned lds_dst){unsigned keep;
  asm volatile("s_mov_b32 %0, m0\n\ts_mov_b32 m0, %2\n\ts_nop 0\n\tglobal_load_lds_dwordx4 %1, off\n\ts_mov_b32 m0, %0":"=&s"(keep):"v"(gsrc),"s"(lds_dst):"memory");}
__device__ __forceinline__ float max3f(float a,float b,float c){float r;asm("v_max3_f32 %0, %1, %2, %3":"=v"(r):"v"(a),"v"(b),"v"(c));return r;}
__device__ __forceinline__ float max2f(float a,float b){float r;asm("v_max_f32_e32 %0, %1, %2":"=v"(r):"v"(a),"v"(b));return r;}
__device__ __forceinline__ float fadd_s(float a,float b){float r;asm("v_add_f32_e32 %0, %1, %2":"=v"(r):"v"(a),"v"(b));return r;}
__device__ __forceinline__ float fsub_s(float a,float b){float r;asm("v_sub_f32_e32 %0, %1, %2":"=v"(r):"v"(a),"v"(b));return r;}
typedef float f32x2_t __attribute__((ext_vector_type(2))); typedef __bf16 bf16x2_t __attribute__((ext_vector_type(2)));
__device__ __forceinline__ unsigned cvtpk_s(float lo,float hi){f32x2_t v={lo,hi};bf16x2_t b=__builtin_convertvector(v,bf16x2_t);return __builtin_bit_cast(unsigned,b);}
#define WAIT_BAR(N) asm volatile("s_waitcnt vmcnt(" #N ") lgkmcnt(0)\n\ts_barrier":::"memory")

__device__ __forceinline__ void qkt(f32x16&p0,f32x16&p1,const char*Kslot,const bf16x8*qr,const f32x16&negm,int r32,int hi){
  const char*kb=Kslot+hi*1024+r32*16;
  #pragma unroll
  for(int d0=0;d0<4;++d0){
    const bf16x8 b0=*reinterpret_cast<const bf16x8*>(kb+d0*2048);
    const bf16x8 b1=*reinterpret_cast<const bf16x8*>(kb+d0*2048+512);
    if(d0==0){p0=__builtin_amdgcn_mfma_f32_32x32x16_bf16(b0,qr[0],negm,0,0,0);p1=__builtin_amdgcn_mfma_f32_32x32x16_bf16(b1,qr[0],negm,0,0,0);}
    else{p0=__builtin_amdgcn_mfma_f32_32x32x16_bf16(b0,qr[d0],p0,0,0,0);p1=__builtin_amdgcn_mfma_f32_32x32x16_bf16(b1,qr[d0],p1,0,0,0);}}
}
typedef __attribute__((address_space(3))) const char* lds_cptr;
typedef short v4i16_t __attribute__((ext_vector_type(4)));
__device__ __forceinline__ void kload8(bf16x8*kf,lds_cptr kp){
  kf[0]=*(const __attribute__((address_space(3))) bf16x8*)(kp);      kf[1]=*(const __attribute__((address_space(3))) bf16x8*)(kp+512);
  kf[2]=*(const __attribute__((address_space(3))) bf16x8*)(kp+2048); kf[3]=*(const __attribute__((address_space(3))) bf16x8*)(kp+2560);
  kf[4]=*(const __attribute__((address_space(3))) bf16x8*)(kp+4096); kf[5]=*(const __attribute__((address_space(3))) bf16x8*)(kp+4608);
  kf[6]=*(const __attribute__((address_space(3))) bf16x8*)(kp+6144); kf[7]=*(const __attribute__((address_space(3))) bf16x8*)(kp+6656);
}
__device__ __forceinline__ void kload2(bf16x8*kf,lds_cptr kp,int j){ kf[2*j]=*(const __attribute__((address_space(3))) bf16x8*)(kp+j*2048); kf[2*j+1]=*(const __attribute__((address_space(3))) bf16x8*)(kp+j*2048+512); }
__device__ __forceinline__ s16x4 vtr(lds_cptr p){ return __builtin_bit_cast(s16x4,__builtin_amdgcn_ds_read_tr16_b64_v4i16((__attribute__((address_space(3))) v4i16_t*)p)); }
__device__ __forceinline__ float rowmax(const f32x16&p0,const f32x16&p1){
  float a=max3f(p0[0],p0[1],p1[0]),b=max3f(p0[2],p0[3],p1[1]);a=max3f(a,p1[2],p1[3]);
  #pragma unroll
  for(int r=4;r<16;r+=4){a=max3f(a,p0[r],p0[r+1]);b=max3f(b,p0[r+2],p0[r+3]);a=max3f(a,p1[r],p1[r+1]);b=max3f(b,p1[r+2],p1[r+3]);}
  const float m=max2f(a,b);
  auto rr=__builtin_amdgcn_permlane32_swap(__float_as_uint(m),__float_as_uint(m),false,false);
  return max2f(__uint_as_float(rr[0]),__uint_as_float(rr[1]));
}
__device__ __forceinline__ void pv(f32x16*o,int vb,bf16x8 pa0,bf16x8 pa1,bf16x8 pa2,bf16x8 pa3){
  #pragma unroll
  for(int d0=0;d0<2;++d0){s16x4 lo[4],hi[4];
    #pragma unroll
    for(int ks=0;ks<4;++ks){
      asm volatile("ds_read_b64_tr_b16 %0,%1 offset:%c2":"=&v"(lo[ks]):"v"(vb),"i"(d0*4096+ks*1024):"memory");
      asm volatile("ds_read_b64_tr_b16 %0,%1 offset:%c2":"=&v"(hi[ks]):"v"(vb),"i"(d0*4096+ks*1024+512):"memory");}
    asm volatile("s_waitcnt lgkmcnt(0)":::"memory");SBAR();
    #define PK(k) (bf16x8){lo[k][0],lo[k][1],lo[k][2],lo[k][3],hi[k][0],hi[k][1],hi[k][2],hi[k][3]}
    o[d0]=__builtin_amdgcn_mfma_f32_32x32x16_bf16(pa0,PK(0),o[d0],0,0,0);
    o[d0]=__builtin_amdgcn_mfma_f32_32x32x16_bf16(pa1,PK(1),o[d0],0,0,0);
    o[d0]=__builtin_amdgcn_mfma_f32_32x32x16_bf16(pa2,PK(2),o[d0],0,0,0);
    o[d0]=__builtin_amdgcn_mfma_f32_32x32x16_bf16(pa3,PK(3),o[d0],0,0,0);
    #undef PK
  }
}

#ifndef ATTN_STORE16
#define ATTN_STORE16(p,v) (*(u32x4*)(p)=(v))
#endif
template<int THRL> __device__ __forceinline__ void attn_unit(int b,int qb,const bf16*Qh,const bf16*__restrict__ Kh_,const bf16*__restrict__ Vh_,bf16*Oh,char*shm){
  const int tid=threadIdx.x,lane=tid&63,r32=lane&31,hi=lane>>5; const int wid=__builtin_amdgcn_readfirstlane(tid>>6);
  const long rowbase=(long)b*SEQ; const int q0=qb*QB;
  const bf16*Qw=Qh+(rowbase+q0+wid*QBLK)*PQK;
  const bf16*Kh=Kh_+rowbase*PQK,*Vh=Vh_+rowbase*PV;
  const unsigned lds0=(unsigned)(uintptr_t)shm;
  float*wsf=(float*)(shm+LDS_WS)+wid*64;
  const bf16*ksrc=Kh+(long)lane*PQK+wid*8;
  const bf16*vsrc=Vh+(long)(16*(wid&3)+(lane>>2))*PV+(wid>>2)*32+(lane&3)*8;
  const unsigned kdst=lds0+LDS_K+wid*1024, vdst=lds0+LDS_V+wid*1024;
  #define DMA_K(t,slot) glds16(ksrc+(long)(t)*KVBLK*PQK,(unsigned)__builtin_amdgcn_readfirstlane(kdst+(slot)))
  #define DMA_V(t,slot) glds16(vsrc+(long)(t)*KVBLK*PV,(unsigned)__builtin_amdgcn_readfirstlane(vdst+(slot)))
  const int vb0=(int)(lds0+LDS_V)+((lane>>4)&1)*32+(lane&3)*8+(4*hi+((lane&15)>>2))*64;
  const char*Kbase=shm+LDS_K; bf16x8 kf[8];
  const lds_cptr shm3=(lds_cptr)shm; const lds_cptr kp0=shm3+LDS_K+hi*1024+r32*16; const lds_cptr vp0=shm3+LDS_V+((lane>>4)&1)*32+(lane&3)*8+(4*hi+((lane&15)>>2))*64;
  const int NT=(q0+QB)/KVBLK;
  DMA_K(0,0);DMA_V(0,0);DMA_K(1,SLOTB);
  bf16x8 qr[4];
  #pragma unroll
  for(int d0=0;d0<4;++d0)qr[d0]=*reinterpret_cast<const bf16x8*>(&Qw[(long)r32*PQK+d0*16+hi*8]);
  float mhat=0.f,l_reg=0.f;f32x16 o[2];o[0]=f32x16{};o[1]=f32x16{};f32x16 negm=f32x16{};asm volatile("":"+v"(negm));
  const int qrel=wid*QBLK+r32;
  #define CMASK(P0,P1,t) do{int jb_=(t)-(NT-4); if(jb_>=0)cmask(P0,P1,jb_,qrel,hi);}while(0)
  bool resc=false;
  #define START(P0,P1) do{ const float rm=rowmax(P0,P1); resc=false; \
    { const float dl=rm; mhat=fadd_s(mhat,dl); \
      _Pragma("unroll") for(int r=0;r<16;++r){P0[r]=fsub_s(P0[r],dl);P1[r]=fsub_s(P1[r],dl);} \
      _Pragma("unroll") for(int r=0;r<16;++r)negm[r]=-mhat; asm volatile("":"+v"(negm)); } \
    _Pragma("unroll") for(int r=0;r<16;++r)P0[r]=__builtin_amdgcn_exp2f(P0[r]); }while(0)
  #define RESC() do{ if(resc){ asm volatile("s_waitcnt lgkmcnt(0)":::"memory"); \
      _Pragma("unroll") for(int d_=0;d_<2;++d_) _Pragma("unroll") for(int r=0;r<16;++r)o[d_][r]*=wsf[crow(r,hi)]; } }while(0)
  f32x16 pA0,pA1,pB0,pB1;
  int sl_prev=0,sl_cur=0,sl_next=SLOTB;
  #define ROT() do{sl_prev=sl_cur;sl_cur=sl_next;sl_next=(sl_next==(NSLOT-1)*SLOTB)?0:sl_next+SLOTB;}while(0)
  DMA_K(2,2*SLOTB);
  WAIT_BAR(3);
  qkt(pA0,pA1,Kbase,qr,negm,r32,hi);asm volatile("s_nop 15\n\ts_nop 7":"+v"(pA0),"+v"(pA1));CMASK(pA0,pA1,0);
  START(pA0,pA1);
  _Pragma("unroll") for(int r=0;r<16;++r)pA1[r]=__builtin_amdgcn_exp2f(pA1[r]);
  WAIT_BAR(0);
  DMA_K(3,0);DMA_V(1,SLOTB);
  ROT();
  kload8(kf,kp0+sl_cur);
  WAIT_BAR(2);
  s16x4 vlo[8],vhi[8]; u32x4 pw0,pw1,pw2,pw3;
  #define PKW(P,B) cvtpk_s(P[B],P[B+1])
  #define PAF(k) __builtin_bit_cast(bf16x8,pw##k)
  #define VFR(i) (bf16x8){vlo[i][0],vlo[i][1],vlo[i][2],vlo[i][3],vhi[i][0],vhi[i][1],vhi[i][2],vhi[i][3]}
  #define PIN(x) asm volatile("":"+v"(x))
  #define MX3(a,b,c) __builtin_fmaxf(__builtin_fmaxf((a),(b)),(c))
  #define GAPA(MF,A0,A1,A2,A3,W0,W1,PW) do{ MF; sacc+=A0; sacc+=A1; sacc+=A2; sacc+=A3; PIN(sacc); W0; W1; PIN(PW); SBAR(); }while(0)
  #define EX(v) __builtin_amdgcn_exp2f(v)
  #define GAPB(MF,X,B) do{ MF; X[B]=EX(X[B]); X[B+1]=EX(X[B+1]); X[B+2]=EX(X[B+2]); X[B+3]=EX(X[B+3]); PIN(X); SBAR(); }while(0)
  #define VRD(i) do{ vlo[i]=vtr(vp_+(((i)>>2)*4096+((i)&3)*1024)); vhi[i]=vtr(vp_+(((i)>>2)*4096+((i)&3)*1024+512)); }while(0)
  #define KRD(G,j) do{ if(G){ kload2(kf,kp0+sl_next,j); SBAR(); } }while(0)
  #define STEP(C0,C1,P0,P1,t,GK,GV,GL) do{ SBAR(); \
    const lds_cptr vp_=vp0+sl_prev; \
    VRD(0); SBAR(); float sacc=(P0[0]+P0[1]); \
    GAPA(C0=__builtin_amdgcn_mfma_f32_32x32x16_bf16(kf[0],qr[0],negm,0,0,0), P0[2],P0[3],P0[4],P0[5],     pw0[0]=PKW(P0,0), pw0[1]=PKW(P0,2), pw0); \
    VRD(4); SBAR(); GAPA(C1=__builtin_amdgcn_mfma_f32_32x32x16_bf16(kf[1],qr[0],negm,0,0,0), P0[6],P0[7],P0[8],P0[9],     pw0[2]=PKW(P0,4), pw0[3]=PKW(P0,6), pw0); \
    VRD(1); SBAR(); GAPA(C0=__builtin_amdgcn_mfma_f32_32x32x16_bf16(kf[2],qr[1],C0,0,0,0),   P0[10],P0[11],P0[12],P0[13], pw1[0]=PKW(P0,8), pw1[1]=PKW(P0,10), pw1); \
    VRD(5); SBAR(); GAPA(C1=__builtin_amdgcn_mfma_f32_32x32x16_bf16(kf[3],qr[1],C1,0,0,0),   P0[14],P0[15],P1[0],P1[1],   pw1[2]=PKW(P0,12),pw1[3]=PKW(P0,14), pw1); \
    VRD(2); SBAR(); GAPA(C0=__builtin_amdgcn_mfma_f32_32x32x16_bf16(kf[4],qr[2],C0,0,0,0),   P1[2],P1[3],P1[4],P1[5],     pw2[0]=PKW(P1,0), pw2[1]=PKW(P1,2), pw2); \
    VRD(6); SBAR(); GAPA(C1=__builtin_amdgcn_mfma_f32_32x32x16_bf16(kf[5],qr[2],C1,0,0,0),   P1[6],P1[7],P1[8],P1[9],     pw2[2]=PKW(P1,4), pw2[3]=PKW(P1,6), pw2); \
    VRD(3); SBAR(); GAPA(C0=__builtin_amdgcn_mfma_f32_32x32x16_bf16(kf[6],qr[3],C0,0,0,0),   P1[10],P1[11],P1[12],P1[13], pw3[0]=PKW(P1,8), pw3[1]=PKW(P1,10), pw3); \
    VRD(7); SBAR(); GAPA(C1=__builtin_amdgcn_mfma_f32_32x32x16_bf16(kf[7],qr[3],C1,0,0,0),   P1[14],P1[15],0.f,0.f,       pw3[2]=PKW(P1,12),pw3[3]=PKW(P1,14), pw3); \
    l_reg+=sacc; \
    if(GK){DMA_K((t)+3,sl_cur);} if(GV){DMA_V((t)+1,sl_next);} \
    CMASK(C0,C1,t); \
    { float a=MX3(C0[0],C0[1],C1[0]),b=MX3(C0[2],C0[3],C1[1]); a=MX3(a,C1[2],C1[3]); \
      _Pragma("unroll") for(int r=4;r<16;r+=4){a=MX3(a,C0[r],C0[r+1]);b=MX3(b,C0[r+2],C0[r+3]);a=MX3(a,C1[r],C1[r+1]);b=MX3(b,C1[r+2],C1[r+3]);} \
      float rm=__builtin_fmaxf(a,b); { auto rr=__builtin_amdgcn_permlane32_swap(__float_as_uint(rm),__float_as_uint(rm),false,false); rm=__builtin_fmaxf(__uint_as_float(rr[0]),__uint_as_float(rr[1])); } \
      resc=false; \
      if(__builtin_expect(__any(rm>(float)THRL),0)){ const float dl=__builtin_fmaxf(rm,0.f); mhat+=dl; \
        _Pragma("unroll") for(int r=0;r<16;++r){C0[r]-=dl;C1[r]-=dl;} \
        _Pragma("unroll") for(int r=0;r<16;++r)negm[r]=-mhat; asm volatile("":"+v"(negm)); \
        const float f=__builtin_amdgcn_exp2f(-dl); l_reg*=f; if(hi==0)wsf[r32]=f; resc=true; } } \
    SBAR(); \
    GAPB(o[0]=__builtin_amdgcn_mfma_f32_32x32x16_bf16(PAF(0),VFR(0),o[0],0,0,0), C0,0); \
    GAPB(o[1]=__builtin_amdgcn_mfma_f32_32x32x16_bf16(PAF(0),VFR(4),o[1],0,0,0), C0,4); \
    KRD(GL,0); GAPB(o[0]=__builtin_amdgcn_mfma_f32_32x32x16_bf16(PAF(1),VFR(1),o[0],0,0,0), C0,8); \
    KRD(GL,1); GAPB(o[1]=__builtin_amdgcn_mfma_f32_32x32x16_bf16(PAF(1),VFR(5),o[1],0,0,0), C0,12); \
    KRD(GL,2); GAPB(o[0]=__builtin_amdgcn_mfma_f32_32x32x16_bf16(PAF(2),VFR(2),o[0],0,0,0), C1,0); \
    KRD(GL,3); GAPB(o[1]=__builtin_amdgcn_mfma_f32_32x32x16_bf16(PAF(2),VFR(6),o[1],0,0,0), C1,4); \
    GAPB(o[0]=__builtin_amdgcn_mfma_f32_32x32x16_bf16(PAF(3),VFR(3),o[0],0,0,0), C1,8); \
    GAPB(o[1]=__builtin_amdgcn_mfma_f32_32x32x16_bf16(PAF(3),VFR(7),o[1],0,0,0), C1,12); \
    }while(0)
  int t=1;
  #undef CMASK
  #define CMASK(P0,P1,t) do{}while(0)
  for(;t+5<NT;t+=2){
    STEP(pB0,pB1,pA0,pA1,t,true,true,true);     WAIT_BAR(2); RESC(); ROT();
    STEP(pA0,pA1,pB0,pB1,t+1,true,true,true);   WAIT_BAR(2); RESC(); ROT();
  }
  #undef CMASK
  #define CMASK(P0,P1,t) do{int jb_=(t)-(NT-4); if(jb_>=0)cmask(P0,P1,jb_,qrel,hi);}while(0)
  #define ENDW(tt) do{ if((tt)+3<NT){WAIT_BAR(2);} else if((tt)+2<NT){WAIT_BAR(1);} else {WAIT_BAR(0);} }while(0)
  for(;t+1<NT;t+=2){
    STEP(pB0,pB1,pA0,pA1,t,(t+3<NT),(t+1<NT),(t+1<NT));       ENDW(t);   RESC(); ROT();
    STEP(pA0,pA1,pB0,pB1,t+1,(t+4<NT),(t+2<NT),(t+2<NT));     ENDW(t+1); RESC(); ROT();
  }
  STEP(pB0,pB1,pA0,pA1,NT-1,false,false,false); RESC();
  { float sacc=pB0[0]+pB0[1]; _Pragma("unroll") for(int r=2;r<16;++r)sacc+=pB0[r]; _Pragma("unroll") for(int r=0;r<16;++r)sacc+=pB1[r]; l_reg+=sacc;
    pw0=(u32x4){PKW(pB0,0),PKW(pB0,2),PKW(pB0,4),PKW(pB0,6)};pw1=(u32x4){PKW(pB0,8),PKW(pB0,10),PKW(pB0,12),PKW(pB0,14)};pw2=(u32x4){PKW(pB1,0),PKW(pB1,2),PKW(pB1,4),PKW(pB1,6)};pw3=(u32x4){PKW(pB1,8),PKW(pB1,10),PKW(pB1,12),PKW(pB1,14)};
    SBAR(); pv(o,vb0+sl_cur,PAF(0),PAF(1),PAF(2),PAF(3)); }
  #undef PKW
  #undef PAF
  #undef VFR
  #undef PIN
  #undef MX3
  #undef GAPA
  #undef GAPB
  #undef EX
  #undef VRD
  #undef KRD
  #undef STEP
  #undef ENDW
  {auto rr=__builtin_amdgcn_permlane32_swap(__float_as_uint(l_reg),__float_as_uint(l_reg),false,false);l_reg=__uint_as_float(rr[0])+__uint_as_float(rr[1]);}
  if(hi==0)wsf[32+r32]=l_reg;asm volatile("s_waitcnt lgkmcnt(0)":::"memory");
  float rli[16];
  #pragma unroll
  for(int r=0;r<16;++r)rli[r]=__builtin_amdgcn_rcpf(wsf[32+crow(r,hi)]);
  bf16*Ow=Oh+(rowbase+q0+wid*QBLK)*PO;
  { bf16*stg=(bf16*)(shm+LDS_OST)+wid*2048;
    #pragma unroll
    for(int r=0;r<16;++r){const int orow=crow(r,hi);
      #pragma unroll
      for(int d0=0;d0<2;++d0)stg[orow*64+d0*32+r32]=__float2bfloat16(o[d0][r]*rli[r]);}
    asm volatile("s_waitcnt lgkmcnt(0)":::"memory");
    #pragma unroll
    for(int i=0;i<4;++i){const int row=i*8+(lane>>3),ch=lane&7; const u32x4 v=*(const u32x4*)(stg+row*64+ch*8); ATTN_STORE16(Ow+(long)row*PO+ch*8,v);} }
  asm volatile("s_waitcnt lgkmcnt(0)\n\ts_barrier":::"memory");
  #undef DMA_K
  #undef DMA_V
  #undef CMASK
  #undef START
  #undef RESC
  #undef ROT
}
constexpr int ATTN_LDS_BYTES=LDS_BYTES;
struct AttnTensors { const bf16* Q; const bf16* K; const bf16* V; bf16* O; };
struct AttnUnit { int combo; int qb; };
struct StaticOrder {
  int vcu;
  __device__ __forceinline__ explicit StaticOrder(int v):vcu(v){}
  __device__ __forceinline__ bool next(int i,AttnUnit&u)const{ if(i>=16)return false; const int s=(vcu&1)*8+(i>>1); u.combo=vcu>>1; u.qb=(i&1)?31-s:s; return true; }
};
template<class Sched,int THRL=8> __device__ __forceinline__ void attn_phase(char*lds,const AttnTensors&T,const Sched&S){
  AttnUnit u;
  for(int i=0;S.next(i,u);++i){ const int half=u.combo&1, hm=(u.combo>>1)&7, b=u.combo>>4, h=hm>>1;
    attn_unit<THRL>(b,u.qb,T.Q+hm*64,T.K+hm*64,T.V+h*128+half*64,T.O+hm*128+half*64,lds); }
}
#undef SBAR
#undef WAIT_BAR
}

namespace attn2 {
using attn_body::bf16; using attn_body::bf16x8; using attn_body::s16x4; using attn_body::f32x16; using attn_body::u32x4; using attn_body::lds_cptr;
using attn_body::glds16; using attn_body::vtr; using attn_body::cvtpk_s; using attn_body::crow;
constexpr int SEQ = 8192, PQ = 512, PC = 1024, SLOT = 32768, NS = 4, LDS_WS = NS * SLOT, LDS_BYTES = LDS_WS + 8 * 64 * 4;
#define A2_LAS __attribute__((address_space(3)))
#define A2_SB() __builtin_amdgcn_sched_barrier(0)
#define A2_WAIT_BAR(N) asm volatile("s_waitcnt vmcnt(" #N ") lgkmcnt(0)\n\ts_barrier" ::: "memory")
template <int THRL, int MAP> __device__ __forceinline__ void attn_unit(int b, int h, int qb, int qbn, bool first, bf16x8 (&qr)[4], const bf16* Q, const bf16* __restrict__ K, const bf16* __restrict__ V, bf16* cat, float lam, const float* gain, char* shm) {
    const int tid = threadIdx.x, lane = tid & 63, r32 = lane & 31, hi = lane >> 5; const int wid = __builtin_amdgcn_readfirstlane(tid >> 6), wq = wid & 3; constexpr int map = MAP;
    const long rowbase = (long)b * SEQ; const int q0 = qb * 128;
    const bf16* Qw = Q + (rowbase + q0 + wq * 32) * PQ + (h * 2 + map) * 64;
    const unsigned lds0 = (unsigned)(uintptr_t)shm; const lds_cptr shm3 = (lds_cptr)shm;
    A2_LAS float* wsf = (A2_LAS float*)(shm3 + LDS_WS) + wid * 64;
    const bf16* ks0 = K + (rowbase + lane) * PQ + (h * 2) * 64 + wid * 8;
    const bf16* vsA = V + (rowbase + 16 * (wid & 3) + (lane >> 2)) * PQ + h * 128 + (wid >> 2) * 32 + (lane & 3) * 8;
#define A2_DMA(t, sl) do { const long o_ = (long)(t) * 64 * PQ; const unsigned d_ = (unsigned)__builtin_amdgcn_readfirstlane(lds0 + (unsigned)(sl) * SLOT + wid * 1024); \
        glds16(ks0 + o_, d_); glds16(ks0 + 64 + o_, d_ + 8192u); glds16(vsA + o_, d_ + 16384u); glds16(vsA + 64 + o_, d_ + 24576u); } while (0)
    if (first) {
#pragma unroll
        for (int d0 = 0; d0 < 4; ++d0) qr[d0] = *reinterpret_cast<const bf16x8*>(&Qw[(long)r32 * PQ + d0 * 16 + hi * 8]);
        A2_DMA(0, 0); A2_DMA(1, 1); }
    const lds_cptr kp0 = shm3 + map * 8192 + hi * 1024 + r32 * 16;
    const lds_cptr vp0 = shm3 + 16384 + ((lane >> 4) & 1) * 32 + (lane & 3) * 8 + (4 * hi + ((lane & 15) >> 2)) * 64;
    float mhat = 0.f, l_reg = 0.f; f32x16 o[4]; o[0] = f32x16{}; o[1] = f32x16{}; o[2] = f32x16{}; o[3] = f32x16{}; f32x16 negm = f32x16{};
    const int NT = 2 * (qb + 1), tvis = 2 * qb + (wq >> 1);
    u32x4 pw[4];
#define A2_PV16(vpx) do { const lds_cptr vq_ = (vpx); \
        _Pragma("unroll") for (int hf = 0; hf < 2; ++hf) { s16x4 wa[16]; \
            _Pragma("unroll") for (int i = 0; i < 8; ++i) { wa[2 * i] = vtr(vq_ + (2 * hf + (i >> 2)) * 4096 + (i & 3) * 1024); wa[2 * i + 1] = vtr(vq_ + (2 * hf + (i >> 2)) * 4096 + (i & 3) * 1024 + 512); } \
            A2_SB(); \
            _Pragma("unroll") for (int i = 0; i < 8; ++i) { const s16x4 lo = wa[2 * i], hh = wa[2 * i + 1]; const bf16x8 vf = (bf16x8){lo[0], lo[1], lo[2], lo[3], hh[0], hh[1], hh[2], hh[3]}; \
                o[2 * hf + (i >> 2)] = __builtin_amdgcn_mfma_f32_32x32x16_bf16(__builtin_bit_cast(bf16x8, pw[i & 3]), vf, o[2 * hf + (i >> 2)], 0, 0, 0); } \
            A2_SB(); } } while (0)
#define A2_QKS(t, FIRST) do { const lds_cptr kp = kp0 + ((t) & 3) * SLOT; bf16x8 kf[8]; \
        _Pragma("unroll") for (int d0 = 0; d0 < 4; ++d0) { kf[2 * d0] = *(const A2_LAS bf16x8*)(kp + d0 * 2048); kf[2 * d0 + 1] = *(const A2_LAS bf16x8*)(kp + d0 * 2048 + 512); } \
        A2_SB(); \
        f32x16 p0, p1; \
        p0 = __builtin_amdgcn_mfma_f32_32x32x16_bf16(kf[0], qr[0], negm, 0, 0, 0); p1 = __builtin_amdgcn_mfma_f32_32x32x16_bf16(kf[1], qr[0], negm, 0, 0, 0); \
        _Pragma("unroll") for (int d0 = 1; d0 < 4; ++d0) { p0 = __builtin_amdgcn_mfma_f32_32x32x16_bf16(kf[2 * d0], qr[d0], p0, 0, 0, 0); p1 = __builtin_amdgcn_mfma_f32_32x32x16_bf16(kf[2 * d0 + 1], qr[d0], p1, 0, 0, 0); } \
        A2_SB(); \
        float rm; \
        { float a = __builtin_fmaxf(__builtin_fmaxf(p0[0], p0[1]), p1[0]), c = __builtin_fmaxf(__builtin_fmaxf(p0[2], p0[3]), p1[1]); a = __builtin_fmaxf(__builtin_fmaxf(a, p1[2]), p1[3]); \
          _Pragma("unroll") for (int r = 4; r < 16; r += 4) { a = __builtin_fmaxf(__builtin_fmaxf(a, p0[r]), p0[r + 1]); c = __builtin_fmaxf(__builtin_fmaxf(c, p0[r + 2]), p0[r + 3]); a = __builtin_fmaxf(__builtin_fmaxf(a, p1[r]), p1[r + 1]); c = __builtin_fmaxf(__builtin_fmaxf(c, p1[r + 2]), p1[r + 3]); } \
          rm = __builtin_fmaxf(a, c); auto rr = __builtin_amdgcn_permlane32_swap(__float_as_uint(rm), __float_as_uint(rm), false, false); rm = __builtin_fmaxf(__uint_as_float(rr[0]), __uint_as_float(rr[1])); } \
        if (FIRST) { mhat = rm; \
            _Pragma("unroll") for (int r = 0; r < 16; ++r) { p0[r] -= rm; p1[r] -= rm; negm[r] = -mhat; } \
        } else if (__any(rm > (float)THRL)) {                                  \
            const float dl = __builtin_fmaxf(rm, 0.f); mhat += dl; \
            _Pragma("unroll") for (int r = 0; r < 16; ++r) { p0[r] -= dl; p1[r] -= dl; negm[r] = -mhat; } \
            const float f = __builtin_amdgcn_exp2f(-dl); l_reg *= f; if (hi == 0) wsf[r32] = f; \
            float fr[16]; \
            _Pragma("unroll") for (int r = 0; r < 16; ++r) fr[r] = wsf[crow(r, hi)]; \
            _Pragma("unroll") for (int d = 0; d < 4; ++d) _Pragma("unroll") for (int r = 0; r < 16; ++r) o[d][r] *= fr[r]; \
        } \
        float sacc = 0.f; \
        _Pragma("unroll") for (int r = 0; r < 16; ++r) { p0[r] = __builtin_amdgcn_exp2f(p0[r]); p1[r] = __builtin_amdgcn_exp2f(p1[r]); } \
        _Pragma("unroll") for (int r = 0; r < 16; ++r) sacc += p0[r] + p1[r]; \
        l_reg += sacc; \
        _Pragma("unroll") for (int j = 0; j < 4; ++j) { pw[0][j] = cvtpk_s(p0[2 * j], p0[2 * j + 1]); pw[1][j] = cvtpk_s(p0[8 + 2 * j], p0[8 + 2 * j + 1]); pw[2][j] = cvtpk_s(p1[2 * j], p1[2 * j + 1]); pw[3][j] = cvtpk_s(p1[8 + 2 * j], p1[8 + 2 * j + 1]); } \
        A2_SB(); } while (0)
    A2_WAIT_BAR(0); if (2 < NT) { A2_DMA(2, 2); }
    A2_QKS(0, true);
    if (MAP == 0) { A2_PV16(vp0); }
    for (int t = 1; t < NT; ++t) {
        if (t + 1 < NT) { A2_WAIT_BAR(4); } else { A2_WAIT_BAR(0); }
        if (t + 2 < NT) { A2_DMA(t + 2, (t + 2) & 3); }
        if (MAP == 1) { A2_PV16(vp0 + ((t - 1) & 3) * SLOT); }
        if (t <= tvis) { A2_QKS(t, false); if (MAP == 0) { A2_PV16(vp0 + (t & 3) * SLOT); } }
    }
    if (MAP == 1 && NT - 1 <= tvis) { A2_PV16(vp0 + ((NT - 1) & 3) * SLOT); }
    { auto rr = __builtin_amdgcn_permlane32_swap(__float_as_uint(l_reg), __float_as_uint(l_reg), false, false); l_reg = __uint_as_float(rr[0]) + __uint_as_float(rr[1]); }
    if (hi == 0) wsf[32 + r32] = l_reg;
    float rli[16];
#pragma unroll
    for (int r = 0; r < 16; ++r) rli[r] = __builtin_amdgcn_rcpf(wsf[32 + crow(r, hi)]);
#pragma unroll
    for (int d = 0; d < 4; ++d)
#pragma unroll
        for (int r = 0; r < 16; ++r) o[d][r] *= rli[r];
    A2_WAIT_BAR(0);
    if (qbn >= 0) {
        A2_DMA(0, 0); A2_DMA(1, 1);
        const bf16* Qn = Q + (rowbase + qbn * 128 + wq * 32) * PQ + (h * 2 + map) * 64;
#pragma unroll
        for (int d0 = 0; d0 < 4; ++d0) qr[d0] = *reinterpret_cast<const bf16x8*>(&Qn[(long)r32 * PQ + d0 * 16 + hi * 8]); }
    A2_LAS float* st = (A2_LAS float*)(shm3 + 2 * SLOT) + wq * 4096 + lane;
    if (map == 1) {
#pragma unroll
        for (int d = 0; d < 4; ++d)
#pragma unroll
            for (int r = 0; r < 16; ++r) st[(d * 16 + r) * 64] = o[d][r];
    }
    A2_WAIT_BAR(0);
    if (map == 0) {
        float g[4];
#pragma unroll
        for (int d = 0; d < 4; ++d) g[d] = gain[32 * d + r32] * 0.8f;
#pragma unroll
        for (int d = 0; d < 4; ++d)
#pragma unroll
            for (int r = 0; r < 16; ++r) o[d][r] -= lam * st[(d * 16 + r) * 64];
        bf16* orow = cat + (rowbase + q0 + wq * 32) * PC + h * 128 + r32;
#pragma unroll
        for (int r = 0; r < 16; ++r) { float ss = (o[0][r] * o[0][r] + o[1][r] * o[1][r]) + (o[2][r] * o[2][r] + o[3][r] * o[3][r]);
            ss += __shfl_xor(ss, 1); ss += __shfl_xor(ss, 2); ss += __shfl_xor(ss, 4); ss += __shfl_xor(ss, 8); ss += __shfl_xor(ss, 16);
            const float rs = 1.0f / sqrtf(ss * (1.0f / 128.0f) + 1e-6f); bf16* op = orow + (long)crow(r, hi) * PC;
#pragma unroll
            for (int d = 0; d < 4; ++d) op[32 * d] = __float2bfloat16(o[d][r] * rs * g[d]); }
    }
    A2_WAIT_BAR(0);
#undef A2_DMA
#undef A2_PV16
#undef A2_QKS
}
template <int THRL = 8> __device__ __forceinline__ void attn_phase(char* lds, int vcu, const bf16* Q, const bf16* K, const bf16* V, bf16* cat, float lam, const float* gain) {
    for (int v = vcu; v < 256; v += (int)gridDim.x) {
        const int bh = v >> 3, j = v & 7;
        bf16x8 qr[4];
        for (int i = 0; i < 8; ++i) { const int qb = 63 - 8 * i - ((i & 1) ? 7 - j : j), qbn = (i < 7) ? 63 - 8 * (i + 1) - (((i + 1) & 1) ? 7 - j : j) : -1;
            if ((threadIdx.x >> 8) == 0) attn_unit<THRL, 0>(bh >> 2, bh & 3, qb, qbn, i == 0, qr, Q, K, V, cat, lam, gain, lds); else attn_unit<THRL, 1>(bh >> 2, bh & 3, qb, qbn, i == 0, qr, Q, K, V, cat, lam, gain, lds); } }
}
#undef A2_WAIT_BAR
#undef A2_SB
#undef A2_LAS
}

#include <hip/hip_cooperative_groups.h>
namespace cg = cooperative_groups;

#ifndef MK_N_LAUNCHES
#define MK_N_LAUNCHES 1
#endif
constexpr int NWAVES = 8, NPH = 10;
constexpr int BATCH = 8, SEQL = 8192, DM = 1024, FF = 2816, NIN = 2048;
constexpr int M = BATCH * SEQL;
constexpr size_t MiB = 1u << 20;
constexpr size_t WS_SSQ = 0;
constexpr size_t WS_CST = 1 * MiB;
constexpr size_t WS_WGU1 = 4 * MiB, WS_WD1 = 16 * MiB, WS_WIN = 22 * MiB, WS_WOUT = 26 * MiB, WS_WPOOL = 28 * MiB, WS_WGU2 = 30 * MiB, WS_WD2 = 42 * MiB;
constexpr size_t WS_A = 64 * MiB;
constexpr size_t WS_B = 192 * MiB;
constexpr size_t WS_C = 544 * MiB;
constexpr size_t WS_D = 672 * MiB;
constexpr size_t WS_E = 800 * MiB;
constexpr size_t WS_END = 928 * MiB;
constexpr int RING_BYTES = 131072, LDS_BYTES = 147456;

#define GAS __attribute__((address_space(1)))
#define LAS __attribute__((address_space(3)))
typedef unsigned short bf16;
typedef unsigned v4u __attribute__((ext_vector_type(4)));
typedef float f32x4 __attribute__((ext_vector_type(4)));
#define LDS_WAIT() asm volatile("s_waitcnt lgkmcnt(0)" ::: "memory")
__device__ __forceinline__ unsigned f2bf(float f) { unsigned u = __builtin_bit_cast(unsigned, f); return (u + 0x7fffu + ((u >> 16) & 1u)) >> 16; }
__device__ __forceinline__ unsigned pk2(float lo, float hi) { return f2bf(lo) | (f2bf(hi) << 16); }
__device__ __forceinline__ unsigned pk2m(float lo, float hi) { return ((f2bf(lo) + 2u) & 0xfffcu) | (((f2bf(hi) + 2u) & 0xfffcu) << 16); }
__device__ __forceinline__ float bflo(unsigned w) { return __uint_as_float(w << 16); }
__device__ __forceinline__ float bfhi(unsigned w) { return __uint_as_float(w & 0xffff0000u); }
__device__ __forceinline__ float wave_sum(float v) {
#pragma unroll
    for (int o = 1; o < 64; o <<= 1) v += __shfl_xor(v, o);
    return v;
}
template <bool MASK> __device__ __forceinline__ void p0_tr_item(const float* W, int ldw, int scol0, const float* gain, int k0, bf16* WT, int K, int drow0, LAS float* scr, int lane) {
    float tv[32];
#pragma unroll
    for (int i = 0; i < 32; ++i) { const int kk = 2 * i + (lane >> 5); tv[i] = W[(size_t)(k0 + kk) * ldw + scol0 + (lane & 31)]; }
    if (gain) {
#pragma unroll
        for (int i = 0; i < 32; ++i) tv[i] *= gain[k0 + 2 * i + (lane >> 5)]; }
#pragma unroll
    for (int i = 0; i < 32; ++i) scr[(2 * i + (lane >> 5)) * 33 + (lane & 31)] = tv[i];
    LDS_WAIT(); asm volatile("" ::: "memory");
    const int c = lane & 7;
#pragma unroll
    for (int j = 0; j < 4; ++j) { const int n = (lane >> 3) + 8 * j; const LAS float* s = scr + (8 * c) * 33 + n;
        v4u o; if constexpr (MASK) { o.x = pk2m(s[0 * 33], s[1 * 33]); o.y = pk2m(s[2 * 33], s[3 * 33]); o.z = pk2m(s[4 * 33], s[5 * 33]); o.w = pk2m(s[6 * 33], s[7 * 33]); }
        else { o.x = pk2(s[0 * 33], s[1 * 33]); o.y = pk2(s[2 * 33], s[3 * 33]); o.z = pk2(s[4 * 33], s[5 * 33]); o.w = pk2(s[6 * 33], s[7 * 33]); }
        *(v4u*)(WT + (size_t)(drow0 + n) * K + k0 + 8 * c) = o; }
    LDS_WAIT(); asm volatile("" ::: "memory");
}

__device__ __forceinline__ void p0_tr_item_f8(const float* W, int ldw, int scol0, float scale, int k0, unsigned char* WT8, int K, int drow0, LAS float* scr, int lane) {
    float tv[32];
#pragma unroll
    for (int i = 0; i < 32; ++i) { const int kk = 2 * i + (lane >> 5); tv[i] = W[(size_t)(k0 + kk) * ldw + scol0 + (lane & 31)]; }
#pragma unroll
    for (int i = 0; i < 32; ++i) scr[(2 * i + (lane >> 5)) * 33 + (lane & 31)] = tv[i] * scale;
    LDS_WAIT(); asm volatile("" ::: "memory");
    const int c = lane & 7;
#pragma unroll
    for (int j = 0; j < 4; ++j) { const int n = (lane >> 3) + 8 * j; const LAS float* s = scr + (8 * c) * 33 + n;
        const unsigned lo = pg8::pk4_fp8(s[0 * 33], s[1 * 33], s[2 * 33], s[3 * 33]), hi = pg8::pk4_fp8(s[4 * 33], s[5 * 33], s[6 * 33], s[7 * 33]);
        *(unsigned long long*)(WT8 + (size_t)(drow0 + n) * K + k0 + 8 * c) = (unsigned long long)lo | ((unsigned long long)hi << 32); }
    LDS_WAIT(); asm volatile("" ::: "memory");
}

#define XB_TMO      128
#define XB_XCNT(j)  (256  + 64 * (j))
#define XB_XSUB(j)  (1280 + 64 * (j))
#define XB_XGEN(j)  (2304 + 64 * (j))
#define XB_TOP      3328
#define XB_TOPGEN   3392
#define XCD_BAR_WORDS 3456
#define XB_SPIN_CAP (1u << 18)

__device__ __forceinline__ unsigned xb_ld(unsigned* p)              { return __hip_atomic_load(p, __ATOMIC_RELAXED, __HIP_MEMORY_SCOPE_AGENT); }
__device__ __forceinline__ unsigned xb_add(unsigned* p, unsigned v) { return __hip_atomic_fetch_add(p, v, __ATOMIC_RELAXED, __HIP_MEMORY_SCOPE_AGENT); }
__device__ __forceinline__ unsigned xb_xcc_id() { return (unsigned)__builtin_amdgcn_s_getreg((3 << 11) | 20) & 0xFu; }
#define XB_SPIN(cond, bar) do { unsigned _sp = 0; while (cond) { __builtin_amdgcn_s_sleep(1); \
    if ((++_sp & 255u) == 0u) { if (xb_ld(&(bar)[XB_TMO])) break; if (_sp > XB_SPIN_CAP) { atomicAdd(&(bar)[XB_TMO], 1u); break; } } } } while (0)

struct XcdBarrier {
    unsigned* bar; unsigned x;
    volatile LAS unsigned* st;
};

__device__ __forceinline__ XcdBarrier xcd_barrier_post(unsigned* bar, volatile LAS unsigned* st) {
    XcdBarrier b; b.bar = bar; b.x = xb_xcc_id(); b.st = st;
    if (threadIdx.x == 0) (void)xb_add(&bar[XB_XCNT(b.x)], 1u);
    return b;
}
__device__ __forceinline__ void xcd_barrier_complete(unsigned* bar, unsigned x, unsigned& nloc, unsigned& nx) {
    const unsigned G = gridDim.x * gridDim.y * gridDim.z;
    unsigned sum, cnt, mine, sp = 0u;
    for (;;) {
        sum = 0u; cnt = 0u; mine = 0u;
#pragma unroll
        for (unsigned j = 0; j < 16; ++j) { const unsigned c = xb_ld(&bar[XB_XCNT(j)]); sum += c; cnt += (c > 0u) ? 1u : 0u; mine = (j == x) ? c : mine; }
        if (sum == G) break;
        __builtin_amdgcn_s_sleep(1);
        if ((++sp & 255u) == 0u) { if (xb_ld(&bar[XB_TMO])) break; if (sp > XB_SPIN_CAP) { atomicAdd(&bar[XB_TMO], 1u); break; } }
    }
    nloc = mine > 0u ? mine : 1u; nx = cnt > 0u ? cnt : 1u;
}

__device__ __forceinline__ void xcd_barrier(const XcdBarrier& b) {
    asm volatile("s_waitcnt vmcnt(0)" ::: "memory");
    __syncthreads();
    if (threadIdx.x == 0) {
        unsigned* bar = b.bar;
        __builtin_amdgcn_s_waitcnt(0);
        unsigned nloc = b.st[0], nx = b.st[1];
        if (nloc == 0u) { xcd_barrier_complete(bar, b.x, nloc, nx); b.st[0] = nloc; b.st[1] = nx; }
        const unsigned old = xb_add(&bar[XB_XSUB(b.x)], 1u);
        const unsigned gen = old / nloc;
        if (old + 1u == (gen + 1u) * nloc) {
            __builtin_amdgcn_fence(__ATOMIC_RELEASE, "agent");
            asm volatile("s_waitcnt vmcnt(0)" ::: "memory");
            const unsigned og = xb_add(&bar[XB_TOP], 1u);
            const unsigned tg = og / nx;
            if (og + 1u == (tg + 1u) * nx) xb_add(&bar[XB_TOPGEN], 1u);
            else XB_SPIN(xb_ld(&bar[XB_TOPGEN]) == tg, bar);
            __builtin_amdgcn_fence(__ATOMIC_ACQUIRE, "agent");
            xb_add(&bar[XB_XGEN(b.x)], 1u);
            asm volatile("s_waitcnt vmcnt(0)" ::: "memory");
        } else {
            XB_SPIN(xb_ld(&bar[XB_XGEN(b.x)]) == gen, bar);
            __builtin_amdgcn_fence(__ATOMIC_ACQUIRE, "agent");
            asm volatile("s_waitcnt vmcnt(0)" ::: "memory");
        }
    }
    __syncthreads();
}

constexpr size_t WS_BAR = 53 * MiB;
constexpr int MISC_OFF = LDS_BYTES - 64;

struct Args { const float* in[20]; float* out; unsigned char* ws; int ph_lo, ph_hi, dummy, pad; };

__global__ void __launch_bounds__(NWAVES * 64, 2) mk_fwd(Args args) {
    extern __shared__ __attribute__((aligned(16))) unsigned char lds[];
    LAS unsigned char* L = (LAS unsigned char*)lds;
    const int tid = threadIdx.x, lane = tid & 63, wave = __builtin_amdgcn_readfirstlane(tid >> 6);
    const int G = gridDim.x, bx = blockIdx.x, vcu = (G % 8 == 0) ? (bx % 8) * (G / 8) + bx / 8 : bx;
    const int gw = vcu * NWAVES + wave, NGW = G * NWAVES;
    unsigned char* ws = args.ws;
    const float* x = args.in[0];
    float* ssq0 = (float*)(ws + WS_SSQ); float* ssq1 = ssq0 + M; float* ssq2 = ssq1 + M; float* ssq3 = ssq2 + M;
    float* cst = (float*)(ws + WS_CST);
    if (args.dummy) { ssq1 = (float*)(ws + 50 * MiB); ssq2 = ssq1; ssq3 = ssq1; }
    bf16 *Wgu1 = (bf16*)(ws + WS_WGU1), *Wd1 = (bf16*)(ws + WS_WD1), *Win = (bf16*)(ws + WS_WIN), *Wout = (bf16*)(ws + WS_WOUT), *Wgu2 = (bf16*)(ws + WS_WGU2), *Wd2 = (bf16*)(ws + WS_WD2);
    bf16 *xb = (bf16*)(ws + WS_A), *x2 = (bf16*)(ws + WS_A), *Hb = (bf16*)(ws + WS_B), *x1 = (bf16*)(ws + WS_C), *x3b = (bf16*)(ws + WS_C), *Ob = (bf16*)(ws + WS_D), *cat = (bf16*)(ws + WS_E);
    bf16 *qb = (bf16*)(ws + WS_B), *kb = qb + (size_t)M * 512, *vb = kb + (size_t)M * 512, *ub = vb + (size_t)M * 512;
    const int lo = args.ph_lo, hi = args.ph_hi;
    volatile LAS unsigned* bst = (volatile LAS unsigned*)(L + MISC_OFF);
    if (tid < 4) bst[tid] = 0u;
    __syncthreads();
    XcdBarrier bar; bar.bar = (unsigned*)(ws + WS_BAR); bar.x = 0; bar.st = bst;
    if (hi - lo > 1) bar = xcd_barrier_post((unsigned*)(ws + WS_BAR), bst);
    if (hi > 1000) cg::this_grid().sync();
#define IN(k) (lo <= (k) && (k) < hi)
#define SEAM(k) do { if (IN(k) && IN((k) + 1)) xcd_barrier(bar); } while (0)

    if (IN(0)) {
        LAS float* scr = (LAS float*)(L + wave * 16384);
        constexpr int I_GU = 16 * 176, I_D = 44 * 32, I_IN = 16 * 64, I_OUT = 8 * 32, NITEMS = 2 * (I_GU + I_D) + I_IN + I_OUT;
        for (int it = gw; it < NITEMS; it += NGW) {
            int r = it;
            if (r < 2 * I_GU) { const int l2 = r >= I_GU; r -= l2 * I_GU; const int kbk = r / 176, nb = r % 176, n0 = 32 * nb, half = (n0 >> 7) & 1, scol0 = 128 * (n0 >> 8) + (n0 & 127);
                const float* W = l2 ? (half ? args.in[17] : args.in[16]) : (half ? args.in[3] : args.in[2]);
                p0_tr_item<true>(W, FF, scol0, l2 ? args.in[15] : args.in[1], 64 * kbk, l2 ? Wgu2 : Wgu1, DM, n0, scr, lane); continue; }
            r -= 2 * I_GU;
            if (r < 2 * I_D) { const int l2 = r >= I_D; r -= l2 * I_D; const int kbk = r / 32, nb = r % 32;
                if (l2) p0_tr_item_f8(args.in[18], DM, 32 * nb, pg8::W8_SCALE, 64 * kbk, (unsigned char*)Wd2, FF, 32 * nb, scr, lane);
                else p0_tr_item<true>(args.in[4], DM, 32 * nb, nullptr, 64 * kbk, Wd1, FF, 32 * nb, scr, lane);
                continue; }
            r -= 2 * I_D;
            if (r < I_IN) { const int kbk = r / 64, nb = r % 64, n0 = 32 * nb; const int scol0 = n0 < 1024 ? ((n0 >> 8) * 256 + 64 * ((n0 >> 5) & 3) + 32 * ((n0 >> 7) & 1)) : n0;
                p0_tr_item<false>(args.in[6], NIN, scol0, args.in[5], 64 * kbk, Win, DM, n0, scr, lane); continue; }
            r -= I_IN;
            { const int kbk = r / 32, nb = r % 32; p0_tr_item<false>(args.in[14], DM, 32 * nb, nullptr, 64 * kbk, Wout, DM, 32 * nb, scr, lane); }
        }
        const int gtid = gw * 64 + lane, NT = NGW * 64;
        for (int it = gw; it < 16 * 128; it += NGW) { const int n = (it & 15) * 64 + lane, k0 = (it >> 4) * 4, g = k0 >> 7, kk = k0 & 127;
            const float* pw = args.in[12] + ((size_t)g * 128 + kk) * 128; const float* sc = args.in[13] + g * 128; const float* wo = args.in[14] + (size_t)(512 + g * 128) * DM + n;
            float acc4[4] = {0.f, 0.f, 0.f, 0.f};
#pragma unroll 16
            for (int j = 0; j < 128; ++j) { const float w = wo[(size_t)j * DM] * sc[j];
#pragma unroll
                for (int e = 0; e < 4; ++e) acc4[e] += pw[e * 128 + j] * w; }
            *(unsigned long long*)(Wout + (size_t)n * DM + 512 + k0) = (unsigned long long)pk2(acc4[0], acc4[1]) | ((unsigned long long)pk2(acc4[2], acc4[3]) << 32); }
        for (int idx = gtid; idx < SEQL * 32; idx += NT) { const int pos = idx >> 5, j = idx & 31;
            const float pw = (float)pow(10000.0, (double)j * (1.0 / 32.0)); const float inv = 1.0f / pw; const float ang = (float)pos * inv;
            const double a = (double)ang, nq = rint(a * 0.63661977236758134308); double r = fma(-nq, 1.57079632679489655800, a); r = fma(-nq, 6.12323399573676603587e-17, r);
            const double r2 = r * r;
            const double sn = r * (1.0 + r2 * (-1.0 / 6 + r2 * (1.0 / 120 + r2 * (-1.0 / 5040 + r2 * (1.0 / 362880 + r2 * (-1.0 / 39916800 + r2 * (1.0 / 6227020800.0)))))));
            const double cs = 1.0 + r2 * (-0.5 + r2 * (1.0 / 24 + r2 * (-1.0 / 720 + r2 * (1.0 / 40320 + r2 * (-1.0 / 3628800 + r2 * (1.0 / 479001600.0 + r2 * (-1.0 / 87178291200.0)))))));
            const int qd = ((int)nq) & 3; const double c = (qd == 0) ? cs : (qd == 1) ? -sn : (qd == 2) ? -cs : sn, s = (qd == 0) ? sn : (qd == 1) ? cs : (qd == 2) ? -sn : -cs;
            *(float2*)(cst + (size_t)idx * 2) = make_float2((float)c, (float)s); }
        for (int idx = gtid; idx < 3 * M / 4; idx += NT) ((f32x4*)(ssq0 + M))[idx] = (f32x4){0.f, 0.f, 0.f, 0.f};
        for (int ch = gw; ch < M / 32; ch += NGW)
#pragma unroll 1
            for (int rr = 0; rr < 32; rr += 4) { const int row = ch * 32 + rr; const f32x4* __restrict__ xr = (const f32x4*)(x + (size_t)row * DM) + lane; f32x4 v[4][4];
#pragma unroll
                for (int q = 0; q < 4; ++q)
#pragma unroll
                    for (int j = 0; j < 4; ++j) v[q][j] = __builtin_nontemporal_load(xr + q * 256 + 64 * j);
#pragma unroll
                for (int q = 0; q < 4; ++q) { float s = 0.f;
#pragma unroll
                    for (int j = 0; j < 4; ++j) s += (v[q][j].x * v[q][j].x + v[q][j].y * v[q][j].y) + (v[q][j].z * v[q][j].z + v[q][j].w * v[q][j].w);
                    s = wave_sum(s); if (lane == 0) ssq0[row + q] = s;
                    unsigned long long* __restrict__ o8 = (unsigned long long*)(xb + (size_t)(row + q) * DM) + lane;
#pragma unroll
                    for (int j = 0; j < 4; ++j) o8[64 * j] = (unsigned long long)pk2(v[q][j].x, v[q][j].y) | ((unsigned long long)pk2(v[q][j].z, v[q][j].w) << 32); } }
    }
    SEAM(0);
    if (IN(1)) { pg8::Gemm g{xb, Wgu1, M, 2 * FF, DM}; pg8::StaticOrder S; S.init(M, 2 * FF, G, bx); pg8::EpiSwiglu<false> E{Hb, ssq0};
        pg8::gemm_phase<pg8::EpiSwiglu<false>, pg8::StaticOrder, true, true>(L, g, S, E); }
    SEAM(1);
    if (IN(2)) { pg8::Gemm g{Hb, Wd1, M, DM, FF}; pg8::StaticOrder S; S.init(M, DM, G, bx); pg8::EpiRes<false> E{xb, x1, ssq1, 0.5f};
        pg8::gemm_phase<pg8::EpiRes<false>, pg8::StaticOrder, true, true>(L, g, S, E); }
    SEAM(2);
    if (IN(3)) { pg8::Gemm g{x1, Win, M, NIN, DM}; pg8::StaticOrder S; S.init(M, NIN, G, bx); pg8::EpiWin E{qb, kb, vb, ub, ssq1, cst, attn_body::C2};
        pg8::gemm_phase<pg8::EpiWin, pg8::StaticOrder, true, true>(L, g, S, E); }
    SEAM(3);
    if (IN(4)) {
        { const float s1 = wave_sum(args.in[7][lane] * args.in[8][lane]), s2 = wave_sum(args.in[9][lane] * args.in[10][lane]);
          const float lam = expf(s1) - expf(s2) + 0.2f;
          attn2::attn_phase<8>((char*)lds, vcu, (const attn_body::bf16*)qb, (const attn_body::bf16*)kb, (const attn_body::bf16*)vb, (attn_body::bf16*)cat, lam, args.in[11]); }
        for (int ch = gw; ch < M / 32; ch += NGW) {
            const int row0 = ch * 32, t0 = row0 & (SEQL - 1), win = 2 << (lane >> 4);
            const bf16* __restrict__ up = ub + (size_t)row0 * 512 + lane * 8; bf16* __restrict__ dp = cat + (size_t)row0 * 1024 + 512 + lane * 8;
            float S[8];
#pragma unroll
            for (int e = 0; e < 8; ++e) S[e] = 0.f;
            { v4u pv[15];
#pragma unroll
              for (int i = 1; i < 16; ++i) { const bool ok = (i < win) && (t0 >= i); pv[i - 1] = *(const v4u*)(up - (ok ? (size_t)i * 512 : 0)); }
#pragma unroll
              for (int i = 1; i < 16; ++i) { const float wgt = ((i < win) && (t0 >= i)) ? 1.f : 0.f; const v4u w = pv[i - 1];
                  S[0] += wgt * bflo(w.x); S[1] += wgt * bfhi(w.x); S[2] += wgt * bflo(w.y); S[3] += wgt * bfhi(w.y); S[4] += wgt * bflo(w.z); S[5] += wgt * bfhi(w.z); S[6] += wgt * bflo(w.w); S[7] += wgt * bfhi(w.w); } }
#pragma unroll 1
            for (int c8 = 0; c8 < 4; ++c8) { v4u nw[8], od[8];
#pragma unroll
                for (int j = 0; j < 8; ++j) { const int r = c8 * 8 + j, ro = r + 1 - win; nw[j] = *(const v4u*)(up + (size_t)r * 512); od[j] = *(const v4u*)(up + ((t0 + ro >= 0) ? (long)ro * 512 : 0)); }
#pragma unroll
                for (int j = 0; j < 8; ++j) { const int r = c8 * 8 + j, t = t0 + r, cnt = (t + 1 < win) ? t + 1 : win; const float ic = 1.0f / (float)cnt, wo = (t + 1 - win >= 0) ? 1.f : 0.f;
                    const v4u w = nw[j], q = od[j];
                    const float nf[8] = {bflo(w.x), bfhi(w.x), bflo(w.y), bfhi(w.y), bflo(w.z), bfhi(w.z), bflo(w.w), bfhi(w.w)}, of[8] = {bflo(q.x), bfhi(q.x), bflo(q.y), bfhi(q.y), bflo(q.z), bfhi(q.z), bflo(q.w), bfhi(q.w)};
                    float d[8];
#pragma unroll
                    for (int e = 0; e < 8; ++e) { const float sf = S[e] + nf[e]; d[e] = sf * ic - nf[e]; S[e] = sf - wo * of[e]; }
                    v4u o; o.x = pk2(d[0], d[1]); o.y = pk2(d[2], d[3]); o.z = pk2(d[4], d[5]); o.w = pk2(d[6], d[7]);
                    *(v4u*)(dp + (size_t)r * 1024) = o; } }
        }
    }
    SEAM(4);
    if (IN(6)) { pg8::Gemm g{cat, Wout, M, DM, DM}; pg8::StaticOrder S; S.init(M, DM, G, bx); pg8::EpiRes<false> E{x1, x2, ssq2, 1.0f};
        pg8::gemm_phase<pg8::EpiRes<false>, pg8::StaticOrder, true, true>(L, g, S, E); }
    SEAM(6);
    if (IN(7)) { pg8::Gemm g{x2, Wgu2, M, 2 * FF, DM}; pg8::StaticOrder S; S.init(M, 2 * FF, G, bx); pg8::EpiSwiglu<true> E{Hb, ssq2};
        pg8::gemm_phase<pg8::EpiSwiglu<true>, pg8::StaticOrder, true, true>(L, g, S, E); }
    SEAM(7);
    if (IN(8)) { pg8::Gemm g{Hb, Wd2, M, DM, FF / 2}; pg8::StaticOrder S; S.init(M, DM, G, bx); pg8::EpiRes<false> E{x2, x3b, ssq3, 0.5f / (pg8::H8_SCALE * pg8::W8_SCALE)};
        pg8::gemm_phase<pg8::EpiRes<false>, pg8::StaticOrder, true, true, true>(L, g, S, E); }
    SEAM(8);
    if (IN(9)) {
        f32x4 gv[4];
#pragma unroll
        for (int j = 0; j < 4; ++j) gv[j] = *(const f32x4*)(args.in[19] + (j >> 1) * 512 + lane * 8 + (j & 1) * 4);
        for (int ch = gw; ch < M / 32; ch += NGW)
#pragma unroll 1
            for (int rr = 0; rr < 32; rr += 8) { const int row = ch * 32 + rr; v4u v[8][2]; float rs[8];
#pragma unroll
                for (int q = 0; q < 8; ++q) { rs[q] = pg8::rstd_of(ssq3[row + q]); const bf16* xr = x3b + (size_t)(row + q) * DM + lane * 8; v[q][0] = *(const v4u*)xr; v[q][1] = *(const v4u*)(xr + 512); }
#pragma unroll
                for (int q = 0; q < 8; ++q) { float* orow = args.out + (size_t)(row + q) * DM + lane * 8;
#pragma unroll
                    for (int hf = 0; hf < 2; ++hf) { const v4u w = v[q][hf];
                        *(f32x4*)(orow + hf * 512) = (f32x4){bflo(w.x), bfhi(w.x), bflo(w.y), bfhi(w.y)} * rs[q] * gv[2 * hf];
                        *(f32x4*)(orow + hf * 512 + 4) = (f32x4){bflo(w.z), bfhi(w.z), bflo(w.w), bfhi(w.w)} * rs[q] * gv[2 * hf + 1]; } } }
    }
#undef IN
#undef SEAM
}

extern "C" void kernel_launch(void* const* d_in, const int* in_sizes, int n_in, void* d_out, int out_size, void* d_ws, size_t ws_size, hipStream_t stream) {
    static int grid = 0;
    if (grid == 0) {
        if (n_in != 20 || in_sizes[0] != M * DM || out_size != M * DM || ws_size < WS_END) { fprintf(stderr, "kernel_launch: unexpected shapes (n_in %d, in0 %d, out %d, ws %zu); nothing launched\n", n_in, n_in > 0 ? in_sizes[0] : -1, out_size, ws_size); grid = -1; return; }
        int dev = 0, cus = 0, per_cu = 0;
        if (hipGetDevice(&dev) != hipSuccess || hipDeviceGetAttribute(&cus, hipDeviceAttributeMultiprocessorCount, dev) != hipSuccess) { grid = -1; return; }
        if (hipFuncSetAttribute((const void*)mk_fwd, hipFuncAttributeMaxDynamicSharedMemorySize, LDS_BYTES) != hipSuccess) { fprintf(stderr, "kernel_launch: hipFuncSetAttribute failed\n"); grid = -1; return; }
        if (hipOccupancyMaxActiveBlocksPerMultiprocessor(&per_cu, (const void*)mk_fwd, NWAVES * 64, LDS_BYTES) != hipSuccess || per_cu < 1) { fprintf(stderr, "kernel_launch: occupancy query says %d\n", per_cu); per_cu = 1; }
        (void)hipGetLastError();
        grid = cus * per_cu;
    }
    if (grid < 0) return;
    Args a{};
    for (int i = 0; i < 20; ++i) a.in[i] = (const float*)d_in[i];
    a.out = (float*)d_out; a.ws = (unsigned char*)d_ws;
#if MK_N_LAUNCHES == 1
    a.ph_lo = 0; a.ph_hi = NPH;
    (void)hipMemsetAsync((char*)d_ws + WS_BAR, 0, XCD_BAR_WORDS * 4, stream);
    void* params[] = {&a};
    const hipError_t e = hipLaunchCooperativeKernel((const void*)mk_fwd, dim3(grid), dim3(NWAVES * 64), params, LDS_BYTES, stream);
    if (e != hipSuccess) fprintf(stderr, "kernel_launch: cooperative launch failed: %s (grid %d)\n", hipGetErrorString(e), grid);
#else
#ifndef MK_PROBE_MASK
#define MK_PROBE_MASK 0
#endif
    for (int p = 0; p < NPH; ++p) { a.ph_lo = p; a.ph_hi = p + 1;
        if ((MK_PROBE_MASK >> p) & 1) { a.dummy = 1; hipLaunchKernelGGL(mk_fwd, dim3(grid), dim3(NWAVES * 64), LDS_BYTES, stream, a); a.dummy = 0; }
        hipLaunchKernelGGL(mk_fwd, dim3(grid), dim3(NWAVES * 64), LDS_BYTES, stream, a); }
#endif
}
```
